# Optimizing an MI355X kernel written in HIP

```python
import math
import jax, jax.numpy as jnp
from jax import lax
import numpy as np

D_MODEL = 2048
BATCH = 1
SEQ = 16384
DEPTH = 2

N_META = 16
GRID_W = 64
Q_BLOCK = 128
RMS_EPS = 1e-6
ROPE_THETA = 500000.0
AXIAL_THETA = 10000.0

A_HEADS = 8
A_Q_RANK = 512
A_KV_RANK = 256
A_NOPE = 128
A_ROPE = 64
A_V = 128
A_IN = A_Q_RANK + A_KV_RANK + A_ROPE

B_HEADS = 8
B_KV_HEADS = 2
B_HEAD_DIM = 128
B_IN = (B_HEADS + 2 * B_KV_HEADS) * B_HEAD_DIM

EVEN_IN = A_IN + B_IN
MIX_WIDTH = A_HEADS * A_V + B_HEADS * B_HEAD_DIM

C_HEADS = 32
C_KV_HEADS = 4
C_HEAD_DIM = 64
C_WINDOW = 128
C_ROT = C_HEAD_DIM // 4
C_QKV = (C_HEADS + 2 * C_KV_HEADS) * C_HEAD_DIM

D_FF = 7168
N_EXPERTS = 8
TOP_K = 2
D_EXPERT = 7168
MOE_BLOCK = 256

N_EVEN = (DEPTH + 1) // 2
N_ODD = DEPTH // 2

kernel_name = 'hybrid_mla_axialgqa_swa_moe_encoder'


def rms_norm(x, g):
    xf = x.astype(jnp.float32)
    y = xf * lax.rsqrt(jnp.mean(xf * xf, axis=-1, keepdims=True) + RMS_EPS)
    return (y * g.astype(jnp.float32)).astype(x.dtype)


def rope_tables(pos, dim, theta):
    inv_freq = theta ** (-jnp.arange(0, dim, 2, dtype=jnp.float32) / dim)
    ang = pos.astype(jnp.float32)[:, None] * inv_freq[None, :]
    return jnp.cos(ang), jnp.sin(ang)


def apply_rope(x, cos, sin):
    half = x.shape[-1] // 2
    xf = x.astype(jnp.float32)
    x1, x2 = xf[..., :half], xf[..., half:]
    c = cos[None, :, None, :]
    s = sin[None, :, None, :]
    return jnp.concatenate([x1 * c - x2 * s, x2 * c + x1 * s], axis=-1).astype(x.dtype)


def axial_rope(x, row_cos, row_sin, col_cos, col_sin):
    half = x.shape[-1] // 2
    return jnp.concatenate([apply_rope(x[..., :half], row_cos, row_sin),
                            apply_rope(x[..., half:], col_cos, col_sin)], axis=-1)


def _attend_block(q, k, v, scale):
    s = jnp.einsum('bqhgd,bkhd->bhgqk', q, k, preferred_element_type=jnp.float32) * scale
    p = jax.nn.softmax(s, axis=-1).astype(v.dtype)
    return jnp.einsum('bhgqk,bkhd->bqhgd', p, v)


def dense_attention(q, k, v, scale):
    bsz, L, hkv, grp, _ = q.shape
    S = L - N_META
    nb = S // Q_BLOCK
    out_meta = _attend_block(q[:, :N_META], k, v, scale)
    qb = jnp.moveaxis(q[:, N_META:].reshape(bsz, nb, Q_BLOCK, hkv, grp, -1), 1, 0)
    out = lax.map(lambda qblk: _attend_block(qblk, k, v, scale), qb)
    out = jnp.moveaxis(out, 0, 1).reshape(bsz, S, hkv, grp, -1)
    return jnp.concatenate([out_meta, out], axis=1)


def _sink_attend(q, k, v, valid, sink_l, scale):
    s = jnp.einsum('bqhgd,bkhd->bhgqk', q, k, preferred_element_type=jnp.float32) * scale
    s = jnp.where(valid, s, -jnp.inf)
    m = jnp.maximum(jnp.max(s, axis=-1, keepdims=True), sink_l)
    e = jnp.exp(s - m)
    p = e / (jnp.sum(e, axis=-1, keepdims=True) + jnp.exp(sink_l - m))
    return jnp.einsum('bhgqk,bkhd->bqhgd', p.astype(v.dtype), v)


def window_attention(q, k, v, sink, scale):
    bsz, L, hkv, grp, _ = q.shape
    S = L - N_META
    nb = S // Q_BLOCK
    W = C_WINDOW
    k_meta, v_meta = k[:, :N_META], v[:, :N_META]
    k_real, v_real = k[:, N_META:], v[:, N_META:]
    sink_l = sink.astype(jnp.float32).reshape(hkv, grp)[None, :, :, None, None]
    pq = jnp.arange(N_META)[:, None]
    pk = jnp.concatenate([jnp.arange(N_META), N_META + jnp.arange(W)])[None, :]
    meta_valid = jnp.abs(pq - pk) <= W
    out_meta = _sink_attend(q[:, :N_META],
                            jnp.concatenate([k_meta, k_real[:, :W]], axis=1),
                            jnp.concatenate([v_meta, v_real[:, :W]], axis=1),
                            meta_valid, sink_l, scale)
    padw = ((0, 0), (W, W), (0, 0), (0, 0))
    k_pad = jnp.pad(k_real, padw)
    v_pad = jnp.pad(v_real, padw)
    qb = jnp.moveaxis(q[:, N_META:].reshape(bsz, nb, Q_BLOCK, hkv, grp, -1), 1, 0)
    a = jnp.arange(Q_BLOCK)[:, None]
    c = jnp.arange(Q_BLOCK + 2 * W)[None, :]
    meta_cols = jnp.ones((Q_BLOCK, N_META), dtype=bool)

    def block(args):
        qblk, i = args
        start = i * Q_BLOCK
        kb = lax.dynamic_slice_in_dim(k_pad, start, Q_BLOCK + 2 * W, axis=1)
        vb = lax.dynamic_slice_in_dim(v_pad, start, Q_BLOCK + 2 * W, axis=1)
        kidx = start - W + c
        band_ok = (jnp.abs(start + a - kidx) <= W) & (kidx >= 0) & (kidx < S)
        valid = jnp.concatenate([meta_cols, band_ok], axis=1)
        return _sink_attend(qblk, jnp.concatenate([k_meta, kb], axis=1),
                            jnp.concatenate([v_meta, vb], axis=1), valid, sink_l, scale)

    out = lax.map(block, (qb, jnp.arange(nb)))
    out = jnp.moveaxis(out, 0, 1).reshape(bsz, S, hkv, grp, -1)
    return jnp.concatenate([out_meta, out], axis=1)


def even_mixer(h, a_cos, a_sin, row_cos, row_sin, col_cos, col_sin,
               w_in, a_q_norm, a_wq_b, a_kv_norm, a_wkv_b, b_q_norm, b_k_norm, w_out):
    bsz, L, _ = h.shape
    z = h @ w_in
    cq, ckv, kr, bq, bk, bv = jnp.split(z, [A_Q_RANK, A_Q_RANK + A_KV_RANK, A_IN,
                                            A_IN + B_HEADS * B_HEAD_DIM,
                                            A_IN + (B_HEADS + B_KV_HEADS) * B_HEAD_DIM], axis=-1)
    qa = (rms_norm(cq, a_q_norm) @ a_wq_b).reshape(bsz, L, A_HEADS, A_NOPE + A_ROPE)
    q_rot = apply_rope(qa[..., A_NOPE:], a_cos, a_sin)
    kv = (rms_norm(ckv, a_kv_norm) @ a_wkv_b).reshape(bsz, L, A_HEADS, A_NOPE + A_V)
    k_nope, v_a = kv[..., :A_NOPE], kv[..., A_NOPE:]
    k_rot = apply_rope(kr[:, :, None, :], a_cos, a_sin)
    q_a = jnp.concatenate([qa[..., :A_NOPE], q_rot], axis=-1)[:, :, :, None, :]
    k_a = jnp.concatenate([k_nope, jnp.broadcast_to(k_rot, (bsz, L, A_HEADS, A_ROPE))], axis=-1)
    o_a = dense_attention(q_a, k_a, v_a, 1.0 / math.sqrt(A_NOPE + A_ROPE))
    o_a = o_a.reshape(bsz, L, A_HEADS * A_V)
    q_b = rms_norm(bq.reshape(bsz, L, B_HEADS, B_HEAD_DIM), b_q_norm)
    k_b = rms_norm(bk.reshape(bsz, L, B_KV_HEADS, B_HEAD_DIM), b_k_norm)
    q_b = axial_rope(q_b, row_cos, row_sin, col_cos, col_sin)
    k_b = axial_rope(k_b, row_cos, row_sin, col_cos, col_sin)
    q_b = q_b.reshape(bsz, L, B_KV_HEADS, B_HEADS // B_KV_HEADS, B_HEAD_DIM)
    v_b = bv.reshape(bsz, L, B_KV_HEADS, B_HEAD_DIM)
    o_b = dense_attention(q_b, k_b, v_b, 1.0 / math.sqrt(B_HEAD_DIM))
    o_b = o_b.reshape(bsz, L, B_HEADS * B_HEAD_DIM)
    return jnp.concatenate([o_a, o_b], axis=-1) @ w_out


def odd_mixer(h, c_cos, c_sin, w_qkv, b_qkv, sink, w_out, b_out):
    bsz, L, _ = h.shape
    z = h @ w_qkv + b_qkv
    q, k, v = jnp.split(z, [C_HEADS * C_HEAD_DIM, (C_HEADS + C_KV_HEADS) * C_HEAD_DIM], axis=-1)
    q = q.reshape(bsz, L, C_HEADS, C_HEAD_DIM)
    k = k.reshape(bsz, L, C_KV_HEADS, C_HEAD_DIM)
    v = v.reshape(bsz, L, C_KV_HEADS, C_HEAD_DIM)
    q = jnp.concatenate([apply_rope(q[..., :C_ROT], c_cos, c_sin), q[..., C_ROT:]], axis=-1)
    k = jnp.concatenate([apply_rope(k[..., :C_ROT], c_cos, c_sin), k[..., C_ROT:]], axis=-1)
    q = q.reshape(bsz, L, C_KV_HEADS, C_HEADS // C_KV_HEADS, C_HEAD_DIM)
    o = window_attention(q, k, v, sink, 1.0 / math.sqrt(C_HEAD_DIM))
    return o.reshape(bsz, L, C_HEADS * C_HEAD_DIM) @ w_out + b_out


def swiglu(h, w_gate, w_up, w_down):
    return (jax.nn.silu(h @ w_gate) * (h @ w_up)) @ w_down


def moe_swiglu(h, router, w_gate, w_up, w_down):
    bsz, L, D = h.shape
    tok = h.reshape(-1, D)
    N = tok.shape[0]
    logits = jnp.einsum('nd,de->ne', tok, router, preferred_element_type=jnp.float32)
    top_val, top_idx = lax.top_k(logits, TOP_K)
    gates = jax.nn.softmax(top_val, axis=-1)
    e_flat = top_idx.reshape(-1).astype(jnp.int32)
    t_flat = jnp.repeat(jnp.arange(N, dtype=jnp.int32), TOP_K)
    g_flat = gates.reshape(-1)
    n_assign = N * TOP_K
    order = jnp.argsort(e_flat * n_assign + jnp.arange(n_assign, dtype=jnp.int32))
    e_sorted, t_sorted, g_sorted = e_flat[order], t_flat[order], g_flat[order]
    counts = jnp.bincount(e_flat, length=N_EXPERTS)
    padded = (counts + MOE_BLOCK - 1) // MOE_BLOCK * MOE_BLOCK
    start = jnp.cumsum(counts) - counts
    pend = jnp.cumsum(padded)
    pstart = pend - padded
    dest = pstart[e_sorted] + (jnp.arange(n_assign, dtype=jnp.int32) - start[e_sorted])
    n_rows = -(-(n_assign + N_EXPERTS * (MOE_BLOCK - 1)) // MOE_BLOCK) * MOE_BLOCK
    n_blocks = n_rows // MOE_BLOCK
    row_tok = jnp.zeros((n_rows,), jnp.int32).at[dest].set(t_sorted)
    row_gate = jnp.zeros((n_rows,), jnp.float32).at[dest].set(g_sorted)
    block_expert = jnp.minimum(
        jnp.searchsorted(pend, jnp.arange(n_blocks, dtype=jnp.int32) * MOE_BLOCK, side='right'),
        N_EXPERTS - 1)
    xs = tok[row_tok].reshape(n_blocks, MOE_BLOCK, D)

    def expert_block(args):
        xb, e = args
        return (jax.nn.silu(xb @ w_gate[e]) * (xb @ w_up[e])) @ w_down[e]

    y = lax.map(expert_block, (xs, block_expert)).reshape(n_rows, D)
    y = y * row_gate[:, None].astype(y.dtype)
    out = jnp.zeros_like(tok).at[row_tok].add(y)
    return out.reshape(bsz, L, D)


def setup_inputs(seed: int = 0) -> dict:
    key = jax.random.key(seed)
    k = jax.random.split(key, 32)
    f32 = jnp.float32

    def w(kk, shape, fan_in):
        return jax.random.normal(kk, shape, f32) * (fan_in ** -0.5)

    def gain(kk, shape):
        return 1.0 + 0.02 * jax.random.normal(kk, shape, f32)

    E, O = N_EVEN, N_ODD
    return {
        'x': jax.random.normal(k[0], (BATCH, SEQ, D_MODEL), f32),
        'meta_tokens': jax.random.normal(k[1], (N_META, D_MODEL), f32),
        'even_attn_pre': gain(k[2], (E, D_MODEL)),
        'even_attn_post': gain(k[3], (E, D_MODEL)),
        'even_w_in': w(k[4], (E, D_MODEL, EVEN_IN), D_MODEL),
        'a_q_norm': gain(k[5], (E, A_Q_RANK)),
        'a_wq_b': w(k[6], (E, A_Q_RANK, A_HEADS * (A_NOPE + A_ROPE)), A_Q_RANK),
        'a_kv_norm': gain(k[7], (E, A_KV_RANK)),
        'a_wkv_b': w(k[8], (E, A_KV_RANK, A_HEADS * (A_NOPE + A_V)), A_KV_RANK),
        'b_q_norm': gain(k[9], (E, B_HEAD_DIM)),
        'b_k_norm': gain(k[10], (E, B_HEAD_DIM)),
        'even_w_out': w(k[11], (E, MIX_WIDTH, D_MODEL), MIX_WIDTH),
        'even_ffn_pre': gain(k[12], (E, D_MODEL)),
        'even_ffn_post': gain(k[13], (E, D_MODEL)),
        'ffn_w_gate': w(k[14], (E, D_MODEL, D_FF), D_MODEL),
        'ffn_w_up': w(k[15], (E, D_MODEL, D_FF), D_MODEL),
        'ffn_w_down': w(k[16], (E, D_FF, D_MODEL), D_FF),
        'odd_attn_pre': gain(k[17], (O, D_MODEL)),
        'odd_attn_post': gain(k[18], (O, D_MODEL)),
        'c_w_qkv': w(k[19], (O, D_MODEL, C_QKV), D_MODEL),
        'c_b_qkv': 0.02 * jax.random.normal(k[20], (O, C_QKV), f32),
        'c_sink': jax.random.normal(k[21], (O, C_HEADS), f32),
        'c_w_out': w(k[22], (O, C_HEADS * C_HEAD_DIM, D_MODEL), C_HEADS * C_HEAD_DIM),
        'c_b_out': 0.02 * jax.random.normal(k[23], (O, D_MODEL), f32),
        'odd_ffn_pre': gain(k[24], (O, D_MODEL)),
        'odd_ffn_post': gain(k[25], (O, D_MODEL)),
        'moe_router': w(k[26], (O, D_MODEL, N_EXPERTS), D_MODEL),
        'moe_w_gate': w(k[27], (O, N_EXPERTS, D_MODEL, D_EXPERT), D_MODEL),
        'moe_w_up': w(k[28], (O, N_EXPERTS, D_MODEL, D_EXPERT), D_MODEL),
        'moe_w_down': w(k[29], (O, N_EXPERTS, D_EXPERT, D_MODEL), D_EXPERT),
    }


def reference(x, meta_tokens, even_attn_pre, even_attn_post, even_w_in, a_q_norm, a_wq_b,
              a_kv_norm, a_wkv_b, b_q_norm, b_k_norm, even_w_out, even_ffn_pre, even_ffn_post,
              ffn_w_gate, ffn_w_up, ffn_w_down, odd_attn_pre, odd_attn_post, c_w_qkv, c_b_qkv,
              c_sink, c_w_out, c_b_out, odd_ffn_pre, odd_ffn_post, moe_router, moe_w_gate,
              moe_w_up, moe_w_down):
    bsz, S, D = x.shape
    L = N_META + S
    h = jnp.concatenate([jnp.broadcast_to(meta_tokens.astype(x.dtype)[None], (bsz, N_META, D)), x], axis=1)
    pos = jnp.arange(L, dtype=jnp.int32)
    a_cos, a_sin = rope_tables(pos, A_ROPE, ROPE_THETA)
    c_cos, c_sin = rope_tables(pos, C_ROT, ROPE_THETA)
    rows = S // GRID_W
    grid_row = jnp.concatenate([jnp.full((N_META,), -1, jnp.int32),
                                jnp.repeat(jnp.arange(rows, dtype=jnp.int32), GRID_W)])
    grid_col = jnp.concatenate([jnp.arange(N_META, dtype=jnp.int32),
                                jnp.tile(jnp.arange(GRID_W, dtype=jnp.int32), rows)])
    row_cos, row_sin = rope_tables(grid_row, B_HEAD_DIM // 2, AXIAL_THETA)
    col_cos, col_sin = rope_tables(grid_col, B_HEAD_DIM // 2, AXIAL_THETA)

    for layer in range(DEPTH):
        i = layer // 2
        if layer % 2 == 0:
            y = even_mixer(rms_norm(h, even_attn_pre[i]), a_cos, a_sin, row_cos, row_sin,
                           col_cos, col_sin, even_w_in[i], a_q_norm[i], a_wq_b[i], a_kv_norm[i],
                           a_wkv_b[i], b_q_norm[i], b_k_norm[i], even_w_out[i])
            h = h + rms_norm(y, even_attn_post[i])
            y = swiglu(rms_norm(h, even_ffn_pre[i]), ffn_w_gate[i], ffn_w_up[i], ffn_w_down[i])
            h = h + rms_norm(y, even_ffn_post[i])
        else:
            y = odd_mixer(rms_norm(h, odd_attn_pre[i]), c_cos, c_sin, c_w_qkv[i], c_b_qkv[i],
                          c_sink[i], c_w_out[i], c_b_out[i])
            h = h + rms_norm(y, odd_attn_post[i])
            y = moe_swiglu(rms_norm(h, odd_ffn_pre[i]), moe_router[i], moe_w_gate[i],
                           moe_w_up[i], moe_w_down[i])
            h = h + rms_norm(y, odd_ffn_post[i])
    return h[:, N_META:]
```

```cpp
#define ONE_BAR 1
#define HANDSCHED 1
#define VDMA 1
#define KDMA_A 1
#define SRCC 1
#define SRCC_ALL 1
#define WFAST 1
#include <hip/hip_runtime.h>
#include <cstdio>
#include <cstdint>
#include <cstddef>
__device__ __forceinline__ int lane_id_asm() { int l; asm volatile("v_mbcnt_lo_u32_b32 %0, -1, 0\n\tv_mbcnt_hi_u32_b32 %0, -1, %0" : "=&v"(l)); return l; }
namespace pg8 {
#define PG8_LAS __attribute__((address_space(3)))
typedef unsigned short bf16_t;
typedef short bf16x8 __attribute__((ext_vector_type(8)));
typedef float f32x4 __attribute__((ext_vector_type(4)));
typedef unsigned u32x4 __attribute__((ext_vector_type(4)));
typedef int i32x4 __attribute__((ext_vector_type(4)));
typedef int i32x8 __attribute__((ext_vector_type(8)));
constexpr int BM = 256, BK = 64, HALF = 128, HTB = HALF * BK * 2  , STAGE_BYTES = 8 * HTB, NXCD = 8, WGM = 8;

__host__ __device__ __forceinline__ int lds_byte(int r, int c) { const int st = (r >> 4) * 2 + (c >> 5), rr = r & 15, cc = c & 31, ob = rr * 64 + cc * 2; return st * 1024 + (ob ^ (((ob >> 9) & 1) << 5)); }
__host__ __device__ __forceinline__ void stage_rc(int b, int& R, int& C) { const int st = b / 1024, sb = b % 1024, swz = sb ^ (((sb >> 9) & 1) << 5); R = (st >> 1) * 16 + swz / 64; C = (st & 1) * 32 + (swz % 64) / 2; }
__host__ __device__ __forceinline__ int perm32(int rho) { const int n = rho >> 4, i = rho & 15; return 8 * (i >> 2) + 4 * n + (i & 3); }

struct Unit { int pm, pn, k0, nt; };
struct Gemm { const bf16_t* A; const bf16_t* Bt; int M, N, K; };

struct StaticOrder {
    int nM, nN, nwg, G, c, wgm;
    __host__ __device__ __forceinline__ void init(int M, int N, int G_, int c_, int wgm_ = WGM) { nM = M / BM; nN = N / BM; nwg = nM * nN; G = G_; c = c_; wgm = wgm_; }
    __host__ __device__ __forceinline__ bool next(int i, Unit& u) const { const long L = (long)i * G + c; if (L >= nwg) return false; map((int)L, u); return true; }
    __host__ __device__ __forceinline__ void map(int L, Unit& u) const {
        int wgid = L; { const int q = nwg / NXCD, r = nwg % NXCD, xcd = wgid % NXCD, off = wgid / NXCD; wgid = (xcd < r ? xcd * (q + 1) : r * (q + 1) + (xcd - r) * q) + off; }
        const int nig = wgm * nN, gid = wgid / nig, fm = gid * wgm, gsz = (nM - fm) < wgm ? (nM - fm) : wgm;
        u.pm = fm + ((wgid % nig) % gsz); u.pn = (wgid % nig) / gsz; u.k0 = 0; u.nt = 0;
    }
    __device__ __forceinline__ void a_ready(const Unit&) const {}
    __device__ __forceinline__ void done(const Unit&) const {}
};

__device__ __forceinline__ unsigned cvt_pk_bf16(float lo, float hi) { unsigned r; asm volatile("v_cvt_pk_bf16_f32 %0, %1, %2" : "=v"(r) : "v"(lo), "v"(hi)); return r; }
typedef float f32x2 __attribute__((ext_vector_type(2)));
__device__ __forceinline__ f32x2 gelu_pk(f32x2 v) {
    const f32x2 av = __builtin_elementwise_abs(v), d = av * 0.2316418882f + 1.0f;
    f32x2 t; t.x = __builtin_amdgcn_rcpf(d.x); t.y = __builtin_amdgcn_rcpf(d.y);
    f32x2 q = t * 0.5307027145f + (-0.7265760135f); q = q * t + 0.7107068705f; q = q * t + (-0.142248368f); q = q * t + 0.127414796f; q = q * t;
    const f32x2 s = (v * v) * (-0.72134752044f);
    f32x2 e; e.x = __builtin_amdgcn_exp2f(s.x); e.y = __builtin_amdgcn_exp2f(s.y);
    const f32x2 m = v * (q * e), r = v - m;
    f32x2 o; o.x = v.x < 0.f ? m.x : r.x; o.y = v.y < 0.f ? m.y : r.y; return o;
}

template <int ACT  > struct EpiBf16 {
    static constexpr bool PERM = true, AFTER_DRAIN = false; static_assert(ACT == 0 || ACT == 1, "EpiBf16: ACT is 0 (none) or 1 (gelu_pk)");
    bf16_t* O; int ldc; const float* bias; int split_cols; size_t split_stride; float scale0;
    __device__ __forceinline__ void operator()(const f32x4 (&acc)[2][2][4][2], const Unit& u, int wr, int wc, int fr, int fq) const {
        const int row0 = u.pm * BM + wr * 64 + fr; int colt = u.pn * BM; bf16_t* base = O;
        float sc = 1.f; if (split_cols) { const int t = colt / split_cols; base += (size_t)t * split_stride; colt -= t * split_cols; if (t == 0) sc = scale0; }
        const int col0 = colt + wc * 32 + 8 * fq, bcol0 = u.pn * BM + wc * 32 + 8 * fq;
        f32x4 bv[2][2];
#pragma unroll
        for (int bj = 0; bj < 2; ++bj)
#pragma unroll
            for (int n = 0; n < 2; ++n) bv[bj][n] = bias ? *(const f32x4*)(bias + bcol0 + bj * HALF + 4 * n) : (f32x4){0.f, 0.f, 0.f, 0.f};
#pragma unroll
        for (int ai = 0; ai < 2; ++ai)
#pragma unroll
            for (int m = 0; m < 4; ++m) { bf16_t* rowp = base + (size_t)(row0 + ai * HALF + m * 16) * ldc + col0;
#pragma unroll
                for (int bj = 0; bj < 2; ++bj) { f32x4 v0 = acc[ai][bj][m][0] + bv[bj][0], v1 = acc[ai][bj][m][1] + bv[bj][1];
                    if (ACT == 1) { f32x2 a = gelu_pk((f32x2){v0[0], v0[1]}), b = gelu_pk((f32x2){v0[2], v0[3]}), c = gelu_pk((f32x2){v1[0], v1[1]}), d = gelu_pk((f32x2){v1[2], v1[3]});
                        v0 = (f32x4){a.x, a.y, b.x, b.y}; v1 = (f32x4){c.x, c.y, d.x, d.y}; }
                    v0 = v0 * sc; v1 = v1 * sc; u32x4 w; w.x = cvt_pk_bf16(v0[0], v0[1]); w.y = cvt_pk_bf16(v0[2], v0[3]); w.z = cvt_pk_bf16(v1[0], v1[1]); w.w = cvt_pk_bf16(v1[2], v1[3]);
                    *(u32x4*)(rowp + bj * HALF) = w; } }
    }
};

template <class Epi, class Sched, bool ALIGN_EPI = false, bool SP2 = false, bool TILED = false, bool FP8 = false>
__device__ __forceinline__ void gemm_phase(PG8_LAS unsigned char* lds, const Gemm g, const Sched& S, const Epi& E, const int wave_id) {
    const int wid = __builtin_amdgcn_readfirstlane(wave_id), tid = wid * 64 + lane_id_asm(), lane = tid & 63, wr = wid >> 2, wc = wid & 3, fr = lane & 15, fq = lane >> 4;
    static_assert(!FP8 || (TILED && SP2), "FP8 operands: tiled layout, SP2 loop");
    constexpr int KEB = FP8 ? 256 : 512;
    const int K = g.K, nt = K / (FP8 ? 2 * BK : BK);
    unsigned voffA[2], voffB[2];
#pragma unroll
    for (int i = 0; i < 2; ++i) { int R, C; stage_rc(tid * 16 + i * 8192, R, C); const int Rb = Epi::PERM ? ((R & ~31) + perm32(R & 31)) : R;
        voffA[i] = TILED ? (unsigned)(R * 64 + C) * 2u : (unsigned)(R * K + C) * 2u; voffB[i] = TILED ? (unsigned)(Rb * 64 + C) * 2u : (unsigned)(Rb * K + C) * 2u; }
    const size_t kstep = TILED ? (size_t)32768 : (size_t)(BK * 2);
    const size_t hstep = TILED ? (size_t)16384 : (size_t)HALF * K * 2;
    const size_t tstep = TILED ? (size_t)K * KEB : 2 * hstep;
    const unsigned ldsw = (unsigned)wid * 1024u;
    const int aoff = lds_byte(wr * 64 + fr, fq * 8), boff = lds_byte(wc * 32 + fr, fq * 8);
#define PG8_SA(b, h) (((b) * 2 + (h)) * HTB)
#define PG8_SB(b, h) ((4 + (b) * 2 + (h)) * HTB)
#define PG8_STAGE(bufoff, gbase, voff) do { _Pragma("unroll") for (int _i = 0; _i < 2; ++_i) \
        __builtin_amdgcn_global_load_lds((const unsigned*)((const char*)(gbase) + (voff)[_i]), (PG8_LAS unsigned*)(lds + (bufoff) + ldsw + _i * 8192), 16, 0, 0); } while (0)
#define PG8_LDA(dst, b, h) do { _Pragma("unroll") for (int m = 0; m < 4; ++m) _Pragma("unroll") for (int k = 0; k < 2; ++k) dst[m][k] = *(const PG8_LAS bf16x8*)(lds + PG8_SA(b, h) + aoff + m * 2048 + k * 1024); } while (0)
#define PG8_LDB(dst, b, h) do { _Pragma("unroll") for (int n = 0; n < 2; ++n) _Pragma("unroll") for (int k = 0; k < 2; ++k) dst[n][k] = *(const PG8_LAS bf16x8*)(lds + PG8_SB(b, h) + boff + n * 2048 + k * 1024); } while (0)
#define PG8_CAT8(x, y) __builtin_shufflevector(__builtin_bit_cast(i32x4, x), __builtin_bit_cast(i32x4, y), 0, 1, 2, 3, 4, 5, 6, 7)
#define PG8_MMA(ai, bj, At, Bt) do { __builtin_amdgcn_s_setprio(1); \
        if constexpr (FP8) { _Pragma("unroll") for (int m = 0; m < 4; ++m) _Pragma("unroll") for (int n = 0; n < 2; ++n) \
            { const i32x8 b8_ = PG8_CAT8(Bt[n][0], Bt[n][1]), a8_ = PG8_CAT8(At[m][0], At[m][1]); asm volatile("v_mfma_f32_16x16x128_f8f6f4 %0, %1, %2, %0" : "+v"(acc[ai][bj][m][n]) : "v"(b8_), "v"(a8_)); } } \
        else { _Pragma("unroll") for (int m = 0; m < 4; ++m) _Pragma("unroll") for (int n = 0; n < 2; ++n) _Pragma("unroll") for (int k = 0; k < 2; ++k) \
            acc[ai][bj][m][n] = __builtin_amdgcn_mfma_f32_16x16x32_bf16(Bt[n][k], At[m][k], acc[ai][bj][m][n], 0, 0, 0); } \
        __builtin_amdgcn_s_setprio(0); } while (0)
#define PG8_WAIT_V(n) asm volatile("s_waitcnt vmcnt(" #n ")" ::: "memory")
#define PG8_WAIT_L(n) asm volatile("s_waitcnt lgkmcnt(" #n ")" ::: "memory")
#define PG8_BAR __builtin_amdgcn_s_barrier()
#define PG8_SCHED __builtin_amdgcn_sched_barrier(0)
    Unit cur, nxt; int ui = 0;
    if (!S.next(0, cur)) return;
    f32x4 acc[2][2][4][2];
#pragma unroll
    for (int a = 0; a < 2; ++a)
#pragma unroll
        for (int b = 0; b < 2; ++b)
#pragma unroll
            for (int m = 0; m < 4; ++m)
#pragma unroll
                for (int n = 0; n < 2; ++n) acc[a][b][m][n] = (f32x4){0.f, 0.f, 0.f, 0.f};
    bf16x8 At[4][2], B0[2][2], B1[2][2];
    const char* cA = (const char*)g.A + (size_t)cur.pm * tstep + (size_t)cur.k0 * (TILED ? KEB : 2); const char* cB = (const char*)g.Bt + (size_t)cur.pn * tstep + (size_t)cur.k0 * (TILED ? KEB : 2);
    int ntc = (cur.nt & 255) ? (cur.nt & 255) : nt;
    S.a_ready(cur);
    if constexpr (SP2) {
        PG8_STAGE(PG8_SB(0, 0), cB, voffB); PG8_STAGE(PG8_SB(0, 1), cB + hstep, voffB); PG8_STAGE(PG8_SA(0, 0), cA, voffA); PG8_STAGE(PG8_SA(0, 1), cA + hstep, voffA);
        if (wr == 1) PG8_BAR;
        PG8_WAIT_V(2); PG8_BAR;
        PG8_STAGE(PG8_SB(1, 0), cB + kstep, voffB); PG8_STAGE(PG8_SA(1, 0), cA + kstep, voffA); PG8_STAGE(PG8_SB(1, 1), cB + hstep + kstep, voffB);
        PG8_WAIT_V(6); PG8_BAR;
    } else {
        PG8_STAGE(PG8_SB(0, 0), cB, voffB); PG8_STAGE(PG8_SA(0, 0), cA, voffA); PG8_STAGE(PG8_SB(0, 1), cB + hstep, voffB); PG8_STAGE(PG8_SA(0, 1), cA + hstep, voffA);
        if (wr == 1) PG8_BAR;
        PG8_WAIT_V(4); PG8_BAR;
        PG8_STAGE(PG8_SB(1, 0), cB + kstep, voffB); PG8_STAGE(PG8_SA(1, 0), cA + kstep, voffA); PG8_STAGE(PG8_SB(1, 1), cB + hstep + kstep, voffB);
        PG8_WAIT_V(6); PG8_BAR;
    }
    for (;;) {
        const bool has_next = S.next(ui + 1, nxt);
        const char* nA = has_next ? (const char*)g.A + (size_t)nxt.pm * tstep + (size_t)nxt.k0 * (TILED ? KEB : 2) : cA; const char* nB = has_next ? (const char*)g.Bt + (size_t)nxt.pn * tstep + (size_t)nxt.k0 * (TILED ? KEB : 2) : cB;
        for (int t = 0; t < ntc; t += 2) {
            const bool last = (t == ntc - 2);
            const char* a1 = cA + (size_t)(t + 1) * kstep;
            const char* a2 = last ? nA : cA + (size_t)(t + 2) * kstep; const char* b2 = last ? nB : cB + (size_t)(t + 2) * kstep;
            const char* a3 = a2 + kstep; const char* b3 = b2 + kstep;
            if (last && has_next) S.a_ready(nxt);
            if constexpr (SP2) {
            PG8_LDB(B0, 0, 0); PG8_LDB(B1, 0, 1); PG8_SCHED; PG8_LDA(At, 0, 0); PG8_STAGE(PG8_SA(1, 1), a1 + hstep, voffA);
            PG8_WAIT_V(8); PG8_WAIT_L(0); PG8_BAR; PG8_MMA(0, 0, At, B0); PG8_MMA(0, 1, At, B1); PG8_BAR; PG8_SCHED;
            PG8_LDA(At, 0, 1); PG8_STAGE(PG8_SB(0, 0), b2, voffB); PG8_STAGE(PG8_SB(0, 1), b2 + hstep, voffB); PG8_STAGE(PG8_SA(0, 0), a2, voffA);
            PG8_WAIT_V(8); PG8_WAIT_L(0); PG8_BAR; PG8_MMA(1, 0, At, B0); PG8_MMA(1, 1, At, B1); PG8_BAR; PG8_SCHED;
            PG8_LDB(B0, 1, 0); PG8_LDB(B1, 1, 1); PG8_SCHED; PG8_LDA(At, 1, 0); PG8_STAGE(PG8_SA(0, 1), a2 + hstep, voffA);
            PG8_WAIT_V(8); PG8_WAIT_L(0); PG8_BAR; PG8_MMA(0, 0, At, B0); PG8_MMA(0, 1, At, B1); PG8_BAR; PG8_SCHED;
            PG8_LDA(At, 1, 1); PG8_STAGE(PG8_SB(1, 0), b3, voffB); PG8_STAGE(PG8_SB(1, 1), b3 + hstep, voffB); PG8_STAGE(PG8_SA(1, 0), a3, voffA);
            PG8_WAIT_V(8); PG8_WAIT_L(0); PG8_BAR; PG8_MMA(1, 0, At, B0); PG8_MMA(1, 1, At, B1); PG8_BAR; PG8_SCHED;
            } else {
            PG8_LDB(B0, 0, 0); PG8_SCHED; PG8_LDA(At, 0, 0); PG8_STAGE(PG8_SA(1, 1), a1 + hstep, voffA);
            PG8_WAIT_L(8); PG8_BAR; PG8_WAIT_L(0); PG8_MMA(0, 0, At, B0); PG8_BAR; PG8_SCHED;
            PG8_LDB(B1, 0, 1); PG8_STAGE(PG8_SB(0, 0), b2, voffB);
            PG8_BAR; PG8_WAIT_L(0); PG8_MMA(0, 1, At, B1); PG8_BAR;
            PG8_LDA(At, 0, 1); PG8_STAGE(PG8_SA(0, 0), a2, voffA);
            PG8_BAR; PG8_WAIT_L(0); PG8_MMA(1, 0, At, B0); PG8_BAR; PG8_SCHED;
            PG8_STAGE(PG8_SB(0, 1), b2 + hstep, voffB);
            PG8_WAIT_V(6); PG8_BAR; PG8_MMA(1, 1, At, B1); PG8_BAR;
            PG8_LDB(B0, 1, 0); PG8_SCHED; PG8_LDA(At, 1, 0); PG8_STAGE(PG8_SA(0, 1), a2 + hstep, voffA);
            PG8_WAIT_L(8); PG8_BAR; PG8_WAIT_L(0); PG8_MMA(0, 0, At, B0); PG8_BAR; PG8_SCHED;
            PG8_LDB(B1, 1, 1); PG8_STAGE(PG8_SB(1, 0), b3, voffB);
            PG8_BAR; PG8_WAIT_L(0); PG8_MMA(0, 1, At, B1); PG8_BAR;
            PG8_LDA(At, 1, 1); PG8_STAGE(PG8_SA(1, 0), a3, voffA);
            PG8_BAR; PG8_WAIT_L(0); PG8_MMA(1, 0, At, B0); PG8_BAR; PG8_SCHED;
            PG8_STAGE(PG8_SB(1, 1), b3 + hstep, voffB);
            PG8_WAIT_V(6); PG8_BAR; PG8_MMA(1, 1, At, B1); PG8_BAR;
            }
        }
        if constexpr (FP8) asm volatile("s_nop 15\n\ts_nop 15" ::: "memory");
        if constexpr (ALIGN_EPI) { if (wr == 0) PG8_BAR; }
        if constexpr (!Epi::AFTER_DRAIN) { E(acc, cur, wr, wc, fr, fq); S.done(cur); }
        if (!has_next) break;
#pragma unroll
        for (int a = 0; a < 2; ++a)
#pragma unroll
            for (int b = 0; b < 2; ++b)
#pragma unroll
                for (int m = 0; m < 4; ++m)
#pragma unroll
                    for (int n = 0; n < 2; ++n) acc[a][b][m][n] = (f32x4){0.f, 0.f, 0.f, 0.f};
        cur = nxt; cA = nA; cB = nB; ++ui; ntc = (cur.nt & 255) ? (cur.nt & 255) : nt;
        if constexpr (ALIGN_EPI) { if (wr == 1) PG8_BAR; }
    }
    PG8_WAIT_V(0);
    if constexpr (!ALIGN_EPI) { if (wr == 0) PG8_BAR; }
    PG8_BAR;
    if constexpr (Epi::AFTER_DRAIN) { E.fused(acc, cur, wr, wc, fr, fq, lds, wid, lane); S.done(cur); }
#undef PG8_SA
#undef PG8_SB
#undef PG8_STAGE
#undef PG8_LDA
#undef PG8_LDB
#undef PG8_MMA
#undef PG8_CAT8
#undef PG8_WAIT_V
#undef PG8_WAIT_L
#undef PG8_BAR
#undef PG8_SCHED
}
}
constexpr int D_MODEL = 2048, SEQ = 16384, N_META = 16, L_TOK = SEQ + N_META, MPAD = 16640;
constexpr int A_HEADS = 8, A_QRANK = 512, A_KVRANK = 256, A_NOPE = 128, A_ROPE = 64, A_V = 128, A_IN = 832;
constexpr int B_HEADS = 8, B_KVH = 2, B_HD = 128;
constexpr int EVEN_IN = 2368, ZLD = 2560;
constexpr int C_HEADS = 32, C_KVH = 4, C_HD = 64, C_QKV = 2560;
constexpr int D_FF = 7168, N_EXP = 8;
constexpr int MOE_ROWS = 136 * 256;
constexpr float RMS_EPS = 1e-6f;
constexpr float SC_X = 32.f, SC_WGU = 1024.f, SC_ACT = 8.f, SC_WDN = 2048.f, SC_Y = 32.f;
__host__ __device__ __forceinline__ int kvrow(int r) { return r < SEQ ? r + 64 : (r < SEQ + 64 ? r - SEQ : r); }
constexpr int QA_LD = A_HEADS * 192, VA_LD = A_HEADS * 128, QB_LD = B_HEADS * 128, KB_LD = B_KVH * 128;

typedef unsigned short bf16_t;
typedef float f32x4 __attribute__((ext_vector_type(4)));
typedef unsigned u32x4 __attribute__((ext_vector_type(4)));
typedef unsigned u32x2 __attribute__((ext_vector_type(2)));

__device__ __forceinline__ float bf2f(unsigned short b) { return __builtin_bit_cast(float, (unsigned)b << 16); }
__device__ __forceinline__ float bflo(unsigned w) { return __builtin_bit_cast(float, w << 16); }
__device__ __forceinline__ float bfhi(unsigned w) { return __builtin_bit_cast(float, w & 0xffff0000u); }
__device__ __forceinline__ unsigned pkbf(float lo, float hi) { return pg8::cvt_pk_bf16(lo, hi); }
__device__ __forceinline__ float silu_f(float x) { return x * __builtin_amdgcn_rcpf(1.0f + __builtin_amdgcn_exp2f(-1.4426950408889634f * x)); }

struct EpiF32 {
    static constexpr bool PERM = false, AFTER_DRAIN = false;
    float* C; int ldc; const float* bias; float* Cpart; int kchunk;
    __device__ __forceinline__ void operator()(const pg8::f32x4 (&acc)[2][2][4][2], const pg8::Unit& u, int wr, int wc, int fr, int fq) const {
        if (u.nt != 0) { float* P = Cpart + (size_t)(u.k0 / kchunk) * 256 * ldc; const int r0 = wr * 64 + fr, c0 = u.pn * 256 + wc * 32 + 4 * fq;
#pragma unroll
            for (int ai = 0; ai < 2; ++ai)
#pragma unroll
                for (int m = 0; m < 4; ++m)
#pragma unroll
                    for (int bj = 0; bj < 2; ++bj)
#pragma unroll
                        for (int n = 0; n < 2; ++n) *(f32x4*)(P + (size_t)(r0 + ai * 128 + m * 16) * ldc + c0 + bj * 128 + n * 16) = acc[ai][bj][m][n];
            return; }
        const int row0 = u.pm * 256 + wr * 64 + fr, col0 = u.pn * 256 + wc * 32 + 4 * fq;
        f32x4 bv[2][2];
#pragma unroll
        for (int bj = 0; bj < 2; ++bj)
#pragma unroll
            for (int n = 0; n < 2; ++n) bv[bj][n] = bias ? *(const f32x4*)(bias + col0 + bj * 128 + n * 16) : (f32x4){0.f, 0.f, 0.f, 0.f};
#pragma unroll
        for (int ai = 0; ai < 2; ++ai)
#pragma unroll
            for (int m = 0; m < 4; ++m) { float* rowp = C + (size_t)(row0 + ai * 128 + m * 16) * ldc + col0;
#pragma unroll
                for (int bj = 0; bj < 2; ++bj)
#pragma unroll
                    for (int n = 0; n < 2; ++n) *(f32x4*)(rowp + bj * 128 + n * 16) = acc[ai][bj][m][n] + bv[bj][n]; }
    }
};
struct EpiYBf16 {
    static constexpr bool PERM = true, AFTER_DRAIN = false;
    bf16_t* Yb; int ldc; const float* bias; float* Cpart; int kchunk;
    __device__ __forceinline__ void operator()(const pg8::f32x4 (&acc)[2][2][4][2], const pg8::Unit& u, int wr, int wc, int fr, int fq) const {
        const int r0 = wr * 64 + fr, c0 = u.pn * 256 + wc * 32 + 8 * fq;
        if (u.nt != 0) { float* P = Cpart + (size_t)(u.k0 / kchunk) * 256 * ldc;
#pragma unroll
            for (int ai = 0; ai < 2; ++ai)
#pragma unroll
                for (int m = 0; m < 4; ++m)
#pragma unroll
                    for (int bj = 0; bj < 2; ++bj) { float* p = P + (size_t)(r0 + ai * 128 + m * 16) * ldc + c0 + bj * 128; *(f32x4*)p = acc[ai][bj][m][0]; *(f32x4*)(p + 4) = acc[ai][bj][m][1]; }
            return; }
        f32x4 bv[2][2];
#pragma unroll
        for (int bj = 0; bj < 2; ++bj)
#pragma unroll
            for (int n = 0; n < 2; ++n) bv[bj][n] = bias ? *(const f32x4*)(bias + c0 + bj * 128 + 4 * n) : (f32x4){0.f, 0.f, 0.f, 0.f};
#pragma unroll
        for (int ai = 0; ai < 2; ++ai)
#pragma unroll
            for (int m = 0; m < 4; ++m) { bf16_t* rowp = Yb + (size_t)(u.pm * 256 + r0 + ai * 128 + m * 16) * ldc + c0;
#pragma unroll
                for (int bj = 0; bj < 2; ++bj) { const f32x4 v0 = acc[ai][bj][m][0] + bv[bj][0], v1 = acc[ai][bj][m][1] + bv[bj][1];
                    u32x4 w; w.x = pkbf(v0[0], v0[1]); w.y = pkbf(v0[2], v0[3]); w.z = pkbf(v1[0], v1[1]); w.w = pkbf(v1[2], v1[3]);
                    *(u32x4*)(rowp + bj * 128) = w; } }
    }
};
struct EpiStoreBf16 {
    static constexpr bool PERM = true, AFTER_DRAIN = false;
    bf16_t* O; int ldc; int pn_mod; bf16_t* O2;
    __device__ __forceinline__ void operator()(const pg8::f32x4 (&acc)[2][2][4][2], const pg8::Unit& u, int wr, int wc, int fr, int fq) const {
        const int row0 = u.pm * 256 + wr * 64 + fr, col0 = (u.pn % pn_mod) * 256 + wc * 32 + 8 * fq; bf16_t* const Ob = u.k0 ? O2 : O;
#pragma unroll
        for (int ai = 0; ai < 2; ++ai)
#pragma unroll
            for (int m = 0; m < 4; ++m) { bf16_t* rowp = Ob + (size_t)(row0 + ai * 128 + m * 16) * ldc + col0;
#pragma unroll
                for (int bj = 0; bj < 2; ++bj) { const f32x4 v0 = acc[ai][bj][m][0], v1 = acc[ai][bj][m][1];
                    u32x4 w; w.x = pkbf(v0[0], v0[1]); w.y = pkbf(v0[2], v0[3]); w.z = pkbf(v1[0], v1[1]); w.w = pkbf(v1[2], v1[3]);
                    *(u32x4*)(rowp + bj * 128) = w; } }
    }
};
struct EpiSwiGLU {
    static constexpr bool PERM = true, AFTER_DRAIN = false;
    bf16_t* O; int ldc; int pn_mod; int tiled;
    float* SP;
    __device__ __forceinline__ void operator()(const pg8::f32x4 (&acc)[2][2][4][2], const pg8::Unit& u, int wr, int wc, int fr, int fq) const {
        if (u.nt != 0) {
            if (wr == 0) { float* p = SP + ((size_t)((u.k0 >> 9) * pn_mod + u.pn) * 16 + fr) * 256 + wc * 32 + 8 * fq;
#pragma unroll
                for (int bj = 0; bj < 2; ++bj) { *(f32x4*)(p + bj * 128) = acc[0][bj][0][0]; *(f32x4*)(p + bj * 128 + 4) = acc[0][bj][0][1]; } }
            return; }
        const int row0 = u.pm * 256 + wr * 64 + fr, col0 = (u.pn % pn_mod) * 128 + wc * 32 + 8 * fq;
#pragma unroll
        for (int ai = 0; ai < 2; ++ai)
#pragma unroll
            for (int m = 0; m < 4; ++m) {
                const f32x4 g0 = acc[ai][0][m][0], g1 = acc[ai][0][m][1], u0 = acc[ai][1][m][0], u1 = acc[ai][1][m][1];
                u32x4 w;
                w.x = pkbf(silu_f(g0[0]) * u0[0], silu_f(g0[1]) * u0[1]); w.y = pkbf(silu_f(g0[2]) * u0[2], silu_f(g0[3]) * u0[3]);
                w.z = pkbf(silu_f(g1[0]) * u1[0], silu_f(g1[1]) * u1[1]); w.w = pkbf(silu_f(g1[2]) * u1[2], silu_f(g1[3]) * u1[3]);
                const int row = row0 + ai * 128 + m * 16;
                bf16_t* p = tiled ? O + ((size_t)(row >> 8) * (ldc >> 6) + (col0 >> 6)) * 16384 + (row & 255) * 64 + (col0 & 63) : O + (size_t)row * ldc + col0;
                *(u32x4*)p = w; }
    }
};
__device__ __forceinline__ unsigned pkf8x4(float a, float b, float c, float d) {
    a = __builtin_amdgcn_fmed3f(a, -448.f, 448.f); b = __builtin_amdgcn_fmed3f(b, -448.f, 448.f); c = __builtin_amdgcn_fmed3f(c, -448.f, 448.f); d = __builtin_amdgcn_fmed3f(d, -448.f, 448.f);
    int w = __builtin_amdgcn_cvt_pk_fp8_f32(a, b, 0, false); w = __builtin_amdgcn_cvt_pk_fp8_f32(c, d, w, true); return (unsigned)w; }
struct EpiSwiGLU8 {
    static constexpr bool PERM = true, AFTER_DRAIN = false;
    unsigned char* O; int ldc; int pn_mod; float sin, sout;
    __device__ __forceinline__ void operator()(const pg8::f32x4 (&acc)[2][2][4][2], const pg8::Unit& u, int wr, int wc, int fr, int fq) const {
        const int row0 = u.pm * 256 + wr * 64 + fr, ct = u.pn % pn_mod, cb = wc * 32 + 8 * fq;
        const float c1 = -1.4426950408889634f * sin, ic2 = 1.0f / (sin * sin * sout);
#pragma unroll
        for (int ai = 0; ai < 2; ++ai)
#pragma unroll
            for (int m = 0; m < 4; ++m) {
                const f32x4 g0 = acc[ai][0][m][0], g1 = acc[ai][0][m][1], u0 = acc[ai][1][m][0], u1 = acc[ai][1][m][1];
#define SWG8(G, U) (((G) * (U)) * __builtin_amdgcn_rcpf(fmaf(__builtin_amdgcn_exp2f((G) * c1), ic2, ic2)))
                u32x2 w;
                w.x = pkf8x4(SWG8(g0[0], u0[0]), SWG8(g0[1], u0[1]), SWG8(g0[2], u0[2]), SWG8(g0[3], u0[3]));
                w.y = pkf8x4(SWG8(g1[0], u1[0]), SWG8(g1[1], u1[1]), SWG8(g1[2], u1[2]), SWG8(g1[3], u1[3]));
#undef SWG8
                const int row = row0 + ai * 128 + m * 16;
                *(u32x2*)(O + ((size_t)(row >> 8) * (ldc >> 7) + ct) * 32768 + (row & 255) * 128 + cb) = w; }
    }
};
__device__ __forceinline__ void rope4(f32x4& v0, f32x4& v1, const f32x4 c, const f32x4 s) {
    float a, b;
    a = v0[0]; b = v0[1]; v0[0] = a * c[0] - b * s[0]; v0[1] = b * c[0] + a * s[0];
    a = v0[2]; b = v0[3]; v0[2] = a * c[1] - b * s[1]; v0[3] = b * c[1] + a * s[1];
    a = v1[0]; b = v1[1]; v1[0] = a * c[2] - b * s[2]; v1[1] = b * c[2] + a * s[2];
    a = v1[2]; b = v1[3]; v1[2] = a * c[3] - b * s[3]; v1[3] = b * c[3] + a * s[3];
}
struct EpiQA {
    static constexpr bool PERM = true, AFTER_DRAIN = false;
    bf16_t* QA; const float* AC; const float* AS;
    __device__ __forceinline__ void operator()(const pg8::f32x4 (&acc)[2][2][4][2], const pg8::Unit& u, int wr, int wc, int fr, int fq) const {
        const int row0 = u.pm * 256 + wr * 64 + fr;
#pragma unroll
        for (int bj = 0; bj < 2; ++bj) {
            const int c0 = u.pn * 256 + bj * 128 + wc * 32 + 8 * fq, d = c0 % 192; const bool rot = d >= 128; const int i0 = rot ? ((d - 128) >> 1) : 0;
#pragma unroll
            for (int ai = 0; ai < 2; ++ai)
#pragma unroll
                for (int m = 0; m < 4; ++m) { const int row = row0 + ai * 128 + m * 16;
                    f32x4 v0 = acc[ai][bj][m][0], v1 = acc[ai][bj][m][1];
                    if (rot) { const f32x4 c = *(const f32x4*)(AC + (size_t)row * 32 + i0), s = *(const f32x4*)(AS + (size_t)row * 32 + i0); rope4(v0, v1, c, s); }
                    u32x4 w; w.x = pkbf(v0[0], v0[1]); w.y = pkbf(v0[2], v0[3]); w.z = pkbf(v1[0], v1[1]); w.w = pkbf(v1[2], v1[3]);
                    *(u32x4*)(QA + (size_t)row * QA_LD + c0) = w; }
        }
    }
};
struct EpiKV {
    static constexpr bool PERM = true, AFTER_DRAIN = false;
    bf16_t* KA; bf16_t* VA;
    __device__ __forceinline__ void operator()(const pg8::f32x4 (&acc)[2][2][4][2], const pg8::Unit& u, int wr, int wc, int fr, int fq) const {
        const int row0 = u.pm * 256 + wr * 64 + fr, h = u.pn, d0 = wc * 32 + 8 * fq;
#pragma unroll
        for (int ai = 0; ai < 2; ++ai)
#pragma unroll
            for (int m = 0; m < 4; ++m) { const int row = row0 + ai * 128 + m * 16;
#pragma unroll
                for (int bj = 0; bj < 2; ++bj) { const f32x4 v0 = acc[ai][bj][m][0], v1 = acc[ai][bj][m][1];
                    u32x4 w; w.x = pkbf(v0[0], v0[1]); w.y = pkbf(v0[2], v0[3]); w.z = pkbf(v1[0], v1[1]); w.w = pkbf(v1[2], v1[3]);
                    const int kr = kvrow(row);
                    bf16_t* p = (bj == 0) ? (KA + (size_t)kr * QA_LD + h * 192 + d0) : (VA + (size_t)kr * VA_LD + h * 128 + d0);
                    *(u32x4*)p = w; } }
    }
};
struct EpiQKV {
    static constexpr bool PERM = true, AFTER_DRAIN = false;
    bf16_t* O; const float* biasp; const float* CC; const float* CS;
    __device__ __forceinline__ void operator()(const pg8::f32x4 (&acc)[2][2][4][2], const pg8::Unit& u, int wr, int wc, int fr, int fq) const {
        const int row0 = u.pm * 256 + wr * 64 + fr;
#pragma unroll
        for (int bj = 0; bj < 2; ++bj) {
            const int c0 = u.pn * 256 + bj * 128 + wc * 32 + 8 * fq, d = c0 & 63; const bool rot = (c0 < 2304) && (d < 16); const int i0 = rot ? (d >> 1) : 0;
            const f32x4 b0 = *(const f32x4*)(biasp + c0), b1 = *(const f32x4*)(biasp + c0 + 4);
#pragma unroll
            for (int ai = 0; ai < 2; ++ai)
#pragma unroll
                for (int m = 0; m < 4; ++m) { const int row = row0 + ai * 128 + m * 16;
                    f32x4 v0 = acc[ai][bj][m][0] + b0, v1 = acc[ai][bj][m][1] + b1;
                    if (rot) { const f32x4 c = *(const f32x4*)(CC + (size_t)row * 8 + i0), s = *(const f32x4*)(CS + (size_t)row * 8 + i0); rope4(v0, v1, c, s); }
                    u32x4 w; w.x = pkbf(v0[0], v0[1]); w.y = pkbf(v0[2], v0[3]); w.z = pkbf(v1[0], v1[1]); w.w = pkbf(v1[2], v1[3]);
                    *(u32x4*)(O + (size_t)row * C_QKV + c0) = w; }
        }
    }
};
struct MoeOrder {
    pg8::StaticOrder S; const int* blk_e; int nN;
    __device__ void init(int nblk, int nN_, int G, int c, const int* be, int wgm_ = 8) { S.init(nblk * 256, nN_ * 256, G, c, wgm_); blk_e = be; nN = nN_; }
    __device__ bool next(int i, pg8::Unit& u) const { if (!S.next(i, u)) return false; const int e = __builtin_amdgcn_readfirstlane(blk_e[u.pm]); u.pn += e * nN; return true; }
    __device__ __forceinline__ void a_ready(const pg8::Unit&) const {}
    __device__ __forceinline__ void done(const pg8::Unit&) const {}
};
struct MoeSplit2Order {
    pg8::StaticOrder S; const int* blk_e; int nN, khalf;
    __device__ void init(int nblk, int nN_, int K, int G, int c, const int* be) { S.init(nblk * 256, 2 * nN_ * 256, G, c); blk_e = be; nN = nN_; khalf = K / 2; }
    __device__ bool next(int i, pg8::Unit& u) const { if (!S.next(i, u)) return false; const int e = __builtin_amdgcn_readfirstlane(blk_e[u.pm]); const int ks = u.pn / nN;
        u.pn = (u.pn - ks * nN) + e * nN; u.k0 = ks * khalf; u.nt = khalf / 64; return true; }
    __device__ __forceinline__ void a_ready(const pg8::Unit&) const {}
    __device__ __forceinline__ void done(const pg8::Unit&) const {}
};
struct MoeTailOrder {
    pg8::StaticOrder S; const int* blk_e; int nN, K, RG, Lf, s, G, c;
    __device__ __forceinline__ static int pick_s(int Lf, int G) { return Lf == 0 ? 1 : (Lf * 4 <= G ? 4 : (Lf * 2 <= G ? 2 : 1)); }
    __device__ __forceinline__ void init(int nblk, int nN_, int K_, int G_, int c_, const int* be) { S.init(nblk * 256, nN_ * 256, G_, c_); blk_e = be; nN = nN_; K = K_; G = G_; c = c_;
        const int U = nblk * nN_; RG = (U / G_) * G_; Lf = U - RG; s = pick_s(Lf, G_); }
    __device__ __forceinline__ bool next(int i, pg8::Unit& u) const {
        const long L = (long)i * G + c;
        if (L < RG) S.map((int)L, u);
        else { const int e = (int)(L - RG); if (e >= Lf * s) return false; const int j = e % Lf, ks = e / Lf; S.map(RG + j, u);
            if (s > 1) { u.k0 = ks * (K / s); u.nt = (K / s / 128) | ((j * s + ks) << 8); } }
        const int ex = __builtin_amdgcn_readfirstlane(blk_e[u.pm]); u.pn += ex * nN; return true;
    }
    __device__ __forceinline__ void a_ready(const pg8::Unit&) const {}
    __device__ __forceinline__ void done(const pg8::Unit&) const {}
};
struct EpiMoeDown {
    static constexpr bool PERM = true, AFTER_DRAIN = false;
    bf16_t* O; int ldc; int pn_mod; float* SP; float sc;
    __device__ __forceinline__ void operator()(const pg8::f32x4 (&acc)[2][2][4][2], const pg8::Unit& u, int wr, int wc, int fr, int fq) const {
        const int r0 = wr * 64 + fr, c0 = wc * 32 + 8 * fq;
        if (u.nt != 0) { float* P = SP + (size_t)(u.nt >> 8) * 65536;
#pragma unroll
            for (int ai = 0; ai < 2; ++ai)
#pragma unroll
                for (int m = 0; m < 4; ++m)
#pragma unroll
                    for (int bj = 0; bj < 2; ++bj) { float* p = P + (r0 + ai * 128 + m * 16) * 256 + c0 + bj * 128; *(f32x4*)p = acc[ai][bj][m][0] * sc; *(f32x4*)(p + 4) = acc[ai][bj][m][1] * sc; }
            return; }
#pragma unroll
        for (int ai = 0; ai < 2; ++ai)
#pragma unroll
            for (int m = 0; m < 4; ++m) { unsigned char* rowp = (unsigned char*)O + (size_t)(u.pm * 256 + r0 + ai * 128 + m * 16) * ldc + (u.pn % pn_mod) * 256 + c0;
#pragma unroll
                for (int bj = 0; bj < 2; ++bj) { const f32x4 v0 = acc[ai][bj][m][0] * (sc * SC_Y), v1 = acc[ai][bj][m][1] * (sc * SC_Y);
                    u32x2 w; w.x = pkf8x4(v0[0], v0[1], v0[2], v0[3]); w.y = pkf8x4(v1[0], v1[1], v1[2], v1[3]);
                    *(u32x2*)(rowp + bj * 128) = w; } }
    }
};
struct MetaSplitOrder {
    pg8::StaticOrder S; int nmain, nN, G, c, kchunk, nsplit;
    __device__ void init(int nN_, int K, int nsplit_, int G_, int c_, int wgm_ = 8) { S.init(64 * 256, nN_ * 256, G_, c_, wgm_); nmain = 64 * nN_; nN = nN_; G = G_; c = c_; nsplit = nsplit_; kchunk = K / nsplit_; }
    __device__ bool next(int i, pg8::Unit& u) const {
        const long L = (long)i * G + c;
        if (L < nmain) return S.next(i, u);
        const int e = (int)(L - nmain); if (e >= nN * nsplit) return false;
        u.pm = 64; u.pn = e % nN; u.k0 = (e / nN) * kchunk; u.nt = kchunk / 64; return true;
    }
    __device__ __forceinline__ void a_ready(const pg8::Unit&) const {}
    __device__ __forceinline__ void done(const pg8::Unit&) const {}
};
struct ProbeOrder {
    MetaSplitOrder S; int zpm, zpn;
    __device__ bool next(int i, pg8::Unit& u) const { if (!S.next(i, u)) return false; if (u.nt == 0) { if (zpm) u.pm = 0; if (zpn) u.pn = 0; } return true; }
    __device__ __forceinline__ void a_ready(const pg8::Unit&) const {}
    __device__ __forceinline__ void done(const pg8::Unit&) const {}
};
struct RowsPlusOrder {
    pg8::StaticOrder S; int nmain, pn_lo, nN, nMr, G, c;
    __device__ void init(int nMr_, int nN_, int pn_lo_, int G_, int c_) { S.init(nMr_ * 256, nN_ * 256, G_, c_); nmain = nMr_ * nN_; pn_lo = pn_lo_; nN = nN_; nMr = nMr_; G = G_; c = c_; }
    __device__ bool next(int i, pg8::Unit& u) const {
        const long L = (long)i * G + c;
        if (L < nmain) return S.next(i, u);
        const int e = (int)(L - nmain); if (e >= nN - pn_lo) return false;
        u.pm = nMr; u.pn = pn_lo + e; u.k0 = 0; u.nt = 0; return true;
    }
    __device__ __forceinline__ void a_ready(const pg8::Unit&) const {}
    __device__ __forceinline__ void done(const pg8::Unit&) const {}
};
namespace att {
#define LAS3 __attribute__((address_space(3)))
using bf16x8 = __attribute__((ext_vector_type(8))) short;
using s16x4  = __attribute__((ext_vector_type(4))) short;
using f32x16 = __attribute__((ext_vector_type(16))) float;
constexpr int NW = 8, QBLK = 32, KVBLK = 64;
constexpr int SHM_V = KVBLK * 128 * 2;
constexpr float LOG2E = 1.4426950408889634f;
#define SBAR() __builtin_amdgcn_sched_barrier(0)
#ifndef QK_SB_MASK
#define QK_SB_MASK 0x1F
#endif
__device__ __forceinline__ int crow(int r, int hi) { return (r & 3) + 8 * (r >> 2) + 4 * hi; }
typedef float f32x2_t __attribute__((ext_vector_type(2))); typedef __bf16 bf16x2_t __attribute__((ext_vector_type(2)));
__device__ __forceinline__ unsigned cvtpk(float lo, float hi) { f32x2_t v = {lo, hi}; bf16x2_t b = __builtin_convertvector(v, bf16x2_t); return __builtin_bit_cast(unsigned, b); }
template <int NMFMA, int NVALU> __device__ __forceinline__ void interleave_qk_sm() {
#ifdef QK_PIPE
  __builtin_amdgcn_sched_group_barrier(0x100, 2, 0);
#pragma unroll
  for (int i = 0; i < NMFMA / 2; ++i) { __builtin_amdgcn_sched_group_barrier(0x100, 2, 0);
    __builtin_amdgcn_sched_group_barrier(0x008, 1, 0); __builtin_amdgcn_sched_group_barrier(0x002, NVALU, 0);
    __builtin_amdgcn_sched_group_barrier(0x008, 1, 0); __builtin_amdgcn_sched_group_barrier(0x002, NVALU, 0); }
#else
#pragma unroll
  for (int i = 0; i < NMFMA; ++i) { __builtin_amdgcn_sched_group_barrier(0x008, 1, 0); __builtin_amdgcn_sched_group_barrier(0x100, 1, 0); __builtin_amdgcn_sched_group_barrier(0x002, NVALU, 0); }
#endif
}
constexpr int KDSTR = 2080;
constexpr int KHSTR = 1040;
__device__ __forceinline__ int kimg(int row, int c8) { return (c8 >> 1) * KDSTR + (c8 & 1) * KHSTR + row * 16; }

__device__ __forceinline__ void partialSM(f32x16& p0, f32x16& p1, float& m_reg, float& mn, float& alpha, const float C, const float thr, const int nvalid, const int hi) {
  if (nvalid < KVBLK) {
#pragma unroll
    for (int r = 0; r < 16; ++r) { const int k = crow(r, hi); if (k >= nvalid) p0[r] = -1e30f; if (k + 32 >= nvalid) p1[r] = -1e30f; }
  }
  float pmax = p0[0];
#pragma unroll
  for (int r = 1; r < 16; ++r) pmax = fmaxf(pmax, p0[r]);
#pragma unroll
  for (int r = 0; r < 16; ++r) pmax = fmaxf(pmax, p1[r]);
  { auto rr = __builtin_amdgcn_permlane32_swap(__float_as_uint(pmax), __float_as_uint(pmax), false, false);
    pmax = fmaxf(__uint_as_float(rr[0]), __uint_as_float(rr[1])); }
  if (__builtin_expect(__all(pmax - m_reg <= thr), 1)) { mn = m_reg; alpha = 1.f; }
  else { mn = fmaxf(m_reg, pmax); alpha = __builtin_amdgcn_exp2f((m_reg - mn) * C); m_reg = mn; }
  const float mnC = -mn * C;
#ifdef QSCALE
  p0 = p0 + mnC; p1 = p1 + mnC;
#else
#pragma unroll
  for (int r = 0; r < 16; ++r) p0[r] = fmaf(p0[r], C, mnC);
#pragma unroll
  for (int r = 0; r < 16; ++r) p1[r] = fmaf(p1[r], C, mnC);
#endif
#pragma unroll
  for (int r = 0; r < 16; ++r) p0[r] = __builtin_amdgcn_exp2f(p0[r]);
}
__device__ __forceinline__ void packP(const f32x16& p0, const f32x16& p1, bf16x8& pa0, bf16x8& pa1, bf16x8& pa2, bf16x8& pa3) {
#define PK4(P, BASE, OUT) do { unsigned a0 = cvtpk(P[BASE + 0], P[BASE + 1]), a1 = cvtpk(P[BASE + 2], P[BASE + 3]);   \
    unsigned b0 = cvtpk(P[BASE + 4], P[BASE + 5]), b1 = cvtpk(P[BASE + 6], P[BASE + 7]);                              \
    auto r0 = __builtin_amdgcn_permlane32_swap(a0, b0, false, false); auto r1 = __builtin_amdgcn_permlane32_swap(a1, b1, false, false); \
    u32x4 w = {r0[0], r1[0], r0[1], r1[1]}; OUT = __builtin_bit_cast(bf16x8, w); } while (0)
  PK4(p0, 0, pa0); PK4(p0, 8, pa1); PK4(p1, 0, pa2); PK4(p1, 8, pa3);
#undef PK4
}
__device__ __forceinline__ void finishSM(f32x16& p0, f32x16& p1, float alpha, float& l_reg, bf16x8& pa0, bf16x8& pa1, bf16x8& pa2, bf16x8& pa3) {
#pragma unroll
  for (int r = 0; r < 16; ++r) p1[r] = __builtin_amdgcn_exp2f(p1[r]);
#ifdef QSCALE
  float ps;
  { const f32x16 t = p0 + p1;
    typedef float f32x8_t __attribute__((ext_vector_type(8))); typedef float f32x4_t __attribute__((ext_vector_type(4)));
    const f32x8_t a = __builtin_shufflevector(t, t, 0, 1, 2, 3, 4, 5, 6, 7) + __builtin_shufflevector(t, t, 8, 9, 10, 11, 12, 13, 14, 15);
    const f32x4_t b = __builtin_shufflevector(a, a, 0, 1, 2, 3) + __builtin_shufflevector(a, a, 4, 5, 6, 7);
    const f32x2_t c2 = __builtin_shufflevector(b, b, 0, 1) + __builtin_shufflevector(b, b, 2, 3);
    ps = c2.x + c2.y; }
#else
  float ps = 0;
#pragma unroll
  for (int r = 0; r < 16; ++r) ps += p0[r];
#pragma unroll
  for (int r = 0; r < 16; ++r) ps += p1[r];
#endif
  { auto rr = __builtin_amdgcn_permlane32_swap(__float_as_uint(ps), __float_as_uint(ps), false, false);
    ps = __uint_as_float(rr[0]) + __uint_as_float(rr[1]); }
  l_reg = l_reg * alpha + ps;
  packP(p0, p1, pa0, pa1, pa2, pa3);
}
template <int DK, int QREG> __device__ __forceinline__ void qkt(f32x16& p0, f32x16& p1, const LAS3 char* Kl  , const bf16x8* qr, const LAS3 char* qls) {
  p0 = f32x16{}; p1 = f32x16{};
#ifdef QK_PIPE
  bf16x8 b0 = *(const LAS3 bf16x8*)(Kl), b1 = *(const LAS3 bf16x8*)(Kl + 512);
#pragma unroll
  for (int d0 = 0; d0 < DK / 16; ++d0) {
    bf16x8 n0 = b0, n1 = b1;
    if (d0 + 1 < DK / 16) { n0 = *(const LAS3 bf16x8*)(Kl + (d0 + 1) * KDSTR); n1 = *(const LAS3 bf16x8*)(Kl + (d0 + 1) * KDSTR + 512); }
    bf16x8 q;
    if (d0 < QREG) q = qr[d0]; else q = *(const volatile LAS3 bf16x8*)(qls + (d0 - QREG) * 1024);
    p0 = __builtin_amdgcn_mfma_f32_32x32x16_bf16(b0, q, p0, 0, 0, 0);
    p1 = __builtin_amdgcn_mfma_f32_32x32x16_bf16(b1, q, p1, 0, 0, 0);
    b0 = n0; b1 = n1; }
#else
#pragma unroll
  for (int d0 = 0; d0 < DK / 16; ++d0) {
    const bf16x8 b0 = *(const LAS3 bf16x8*)(Kl + d0 * KDSTR);
    const bf16x8 b1 = *(const LAS3 bf16x8*)(Kl + d0 * KDSTR + 512);
    bf16x8 q;
    if (d0 < QREG) q = qr[d0]; else q = *(const volatile LAS3 bf16x8*)(qls + (d0 - QREG) * 1024);
    p0 = __builtin_amdgcn_mfma_f32_32x32x16_bf16(b0, q, p0, 0, 0, 0);
    p1 = __builtin_amdgcn_mfma_f32_32x32x16_bf16(b1, q, p1, 0, 0, 0); }
#endif
}
template <int NCB> __device__ __forceinline__ int v_st(int k, int c) { const int kk = (k & ~0xC) | ((k & 4) << 1) | ((k & 8) >> 1); return ((kk >> 3) * NCB + (c >> 5)) * 512 + ((kk & 7) * 32 + (c & 31)) * 2; }
__device__ __forceinline__ int v_rd_base(int lane) { return ((lane & 3) << 3) | (((lane >> 2) & 3) << 6) | (((lane >> 4) & 1) << 5) | (((lane >> 5) & 1) << 8); }
template <int NCB> constexpr int v_rd_off(int d0, int ks, int half) { return d0 * 512 + (2 * ks + half) * NCB * 512; }
template <int OFF> __device__ __forceinline__ s16x4 tr_read(int vb) {
  s16x4 r; asm volatile("ds_read_b64_tr_b16 %0, %1 offset:%2" : "=&v"(r) : "v"(vb), "i"(OFF) : "memory"); return r;
}
template <int NCB, int D0> __device__ __forceinline__ void pv_one(f32x16& od, int vb, bf16x8 pa0, bf16x8 pa1, bf16x8 pa2, bf16x8 pa3) {
  const s16x4 l0 = tr_read<v_rd_off<NCB>(D0, 0, 0)>(vb), h0 = tr_read<v_rd_off<NCB>(D0, 0, 1)>(vb), l1 = tr_read<v_rd_off<NCB>(D0, 1, 0)>(vb), h1 = tr_read<v_rd_off<NCB>(D0, 1, 1)>(vb);
  const s16x4 l2 = tr_read<v_rd_off<NCB>(D0, 2, 0)>(vb), h2 = tr_read<v_rd_off<NCB>(D0, 2, 1)>(vb), l3 = tr_read<v_rd_off<NCB>(D0, 3, 0)>(vb), h3 = tr_read<v_rd_off<NCB>(D0, 3, 1)>(vb);
  asm volatile("s_waitcnt lgkmcnt(0)" ::: "memory"); SBAR();
#define PKV(L, H) (bf16x8){L[0], L[1], L[2], L[3], H[0], H[1], H[2], H[3]}
  od = __builtin_amdgcn_mfma_f32_32x32x16_bf16(pa0, PKV(l0, h0), od, 0, 0, 0);
  od = __builtin_amdgcn_mfma_f32_32x32x16_bf16(pa1, PKV(l1, h1), od, 0, 0, 0);
  od = __builtin_amdgcn_mfma_f32_32x32x16_bf16(pa2, PKV(l2, h2), od, 0, 0, 0);
  od = __builtin_amdgcn_mfma_f32_32x32x16_bf16(pa3, PKV(l3, h3), od, 0, 0, 0);
#undef PKV
}
template <int NCB, int D0> __device__ __forceinline__ void v_read(int vb, s16x4 (&f)[8]) {
  f[0] = tr_read<v_rd_off<NCB>(D0, 0, 0)>(vb); f[1] = tr_read<v_rd_off<NCB>(D0, 0, 1)>(vb); f[2] = tr_read<v_rd_off<NCB>(D0, 1, 0)>(vb); f[3] = tr_read<v_rd_off<NCB>(D0, 1, 1)>(vb);
  f[4] = tr_read<v_rd_off<NCB>(D0, 2, 0)>(vb); f[5] = tr_read<v_rd_off<NCB>(D0, 2, 1)>(vb); f[6] = tr_read<v_rd_off<NCB>(D0, 3, 0)>(vb); f[7] = tr_read<v_rd_off<NCB>(D0, 3, 1)>(vb);
}
__device__ __forceinline__ void v_mma(f32x16& od, const s16x4 (&f)[8], bf16x8 pa0, bf16x8 pa1, bf16x8 pa2, bf16x8 pa3) {
#define PKV(L, H) (bf16x8){L[0], L[1], L[2], L[3], H[0], H[1], H[2], H[3]}
  od = __builtin_amdgcn_mfma_f32_32x32x16_bf16(pa0, PKV(f[0], f[1]), od, 0, 0, 0);
  od = __builtin_amdgcn_mfma_f32_32x32x16_bf16(pa1, PKV(f[2], f[3]), od, 0, 0, 0);
  od = __builtin_amdgcn_mfma_f32_32x32x16_bf16(pa2, PKV(f[4], f[5]), od, 0, 0, 0);
  od = __builtin_amdgcn_mfma_f32_32x32x16_bf16(pa3, PKV(f[6], f[7]), od, 0, 0, 0);
#undef PKV
}
#define LGKM_WAIT(n) asm volatile("s_waitcnt lgkmcnt(" #n ")" ::: "memory")
__device__ __forceinline__ void pv_sm(f32x16* o, int vb, bf16x8 pa0, bf16x8 pa1, bf16x8 pa2, bf16x8 pa3, f32x16& p0, f32x16& p1, float& m_reg, float& mn, float& alpha, const float C, const float thr) {
#ifdef PV_PIPE
  s16x4 fa[8], fb[8];
  v_read<4, 0>(vb, fa); v_read<4, 1>(vb, fb); LGKM_WAIT(8); SBAR();
  v_mma(o[0], fa, pa0, pa1, pa2, pa3);
#else
  pv_one<4, 0>(o[0], vb, pa0, pa1, pa2, pa3);
#endif
  float pmA = p0[0];
#pragma unroll
  for (int r = 1; r < 16; ++r) pmA = fmaxf(pmA, p0[r]);
#ifdef PV_PIPE
  SBAR(); v_read<4, 2>(vb, fa); LGKM_WAIT(8); SBAR();
  v_mma(o[1], fb, pa0, pa1, pa2, pa3);
#else
  pv_one<4, 1>(o[1], vb, pa0, pa1, pa2, pa3);
#endif
  float pmax = p1[0];
#pragma unroll
  for (int r = 1; r < 16; ++r) pmax = fmaxf(pmax, p1[r]);
  pmax = fmaxf(pmax, pmA);
  { auto rr = __builtin_amdgcn_permlane32_swap(__float_as_uint(pmax), __float_as_uint(pmax), false, false);
    pmax = fmaxf(__uint_as_float(rr[0]), __uint_as_float(rr[1])); }
  const bool keep = __all(pmax - m_reg <= thr);
  mn = keep ? m_reg : fmaxf(m_reg, pmax); alpha = __builtin_amdgcn_exp2f((m_reg - mn) * C); m_reg = mn;
  const float mnC = -mn * C;
#ifdef PV_PIPE
  SBAR(); v_read<4, 3>(vb, fb); LGKM_WAIT(8); SBAR();
  v_mma(o[2], fa, pa0, pa1, pa2, pa3);
#else
  pv_one<4, 2>(o[2], vb, pa0, pa1, pa2, pa3);
#endif
#ifdef QSCALE
  p0 = p0 + mnC; p1 = p1 + mnC;
#else
#pragma unroll
  for (int r = 0; r < 16; ++r) p0[r] = fmaf(p0[r], C, mnC);
#pragma unroll
  for (int r = 0; r < 16; ++r) p1[r] = fmaf(p1[r], C, mnC);
#endif
#ifdef PV_PIPE
  SBAR(); LGKM_WAIT(0); SBAR();
  v_mma(o[3], fb, pa0, pa1, pa2, pa3);
#else
  pv_one<4, 3>(o[3], vb, pa0, pa1, pa2, pa3);
#endif
#pragma unroll
  for (int r = 0; r < 16; ++r) p0[r] = __builtin_amdgcn_exp2f(p0[r]);
}
__device__ __forceinline__ void pv_d0(f32x16* o, int vb, bf16x8 pa0, bf16x8 pa1, bf16x8 pa2, bf16x8 pa3) {
  pv_one<4, 0>(o[0], vb, pa0, pa1, pa2, pa3); pv_one<4, 1>(o[1], vb, pa0, pa1, pa2, pa3); pv_one<4, 2>(o[2], vb, pa0, pa1, pa2, pa3); pv_one<4, 3>(o[3], vb, pa0, pa1, pa2, pa3);
}

#ifdef HANDSCHED
__device__ __forceinline__ bf16x8 perm4(unsigned a0, unsigned a1, unsigned b0, unsigned b1) {
  auto r0 = __builtin_amdgcn_permlane32_swap(a0, b0, false, false); auto r1 = __builtin_amdgcn_permlane32_swap(a1, b1, false, false);
  u32x4 w = {r0[0], r1[0], r0[1], r1[1]}; return __builtin_bit_cast(bf16x8, w); }
__device__ __forceinline__ s16x4 trb(const LAS3 char* p) { return __builtin_amdgcn_ds_read_tr16_b64_v4i16((LAS3 s16x4*)p); }
template <int DK, int QREG, bool SC, class Hook>
__device__ __forceinline__ void hs_step(f32x16& negM, f32x16& n0, f32x16& n1, const LAS3 char* Kl, const bf16x8* qr, const LAS3 char* qls,
                                        f32x16& f0, f32x16& f1, const float alphaPrev, float& l_reg, f32x16* o, const LAS3 char* vb,
                                        float& m_reg, float& mn, float& alpha, const float C, const float thr, float& fC, float& fM, const Hook& hook) {
  constexpr int NS = DK / 16, NSLOT = 2 * NS;
  n0 = f32x16{}; n1 = f32x16{};
  bf16x8 kb0 = *(const LAS3 bf16x8*)(Kl), kb1 = *(const LAS3 bf16x8*)(Kl + 512);
  float s0 = 0.f, s1 = 0.f; unsigned c0[8], c1[8]; bf16x8 pa[4];
#define FIN_SLOT(i) do { \
    if ((i) < 16) { f1[(i) & 15] = SC ? __builtin_amdgcn_exp2f(f1[(i) & 15]) : __builtin_amdgcn_exp2f(fmaf(f1[(i) & 15], fC, fM)); s0 += f0[(i) & 15]; if ((i) > 0) s1 += f1[((i) - 1) & 15]; \
      if ((i) < 8) c0[(i) & 7] = cvtpk(f0[(2 * (i)) & 15], f0[(2 * (i) + 1) & 15]); else if ((i) < 15) c1[((i) - 8) & 7] = cvtpk(f1[(2 * ((i) - 8)) & 15], f1[(2 * ((i) - 8) + 1) & 15]); } \
    if ((i) == 4) pa[0] = perm4(c0[0], c0[1], c0[2], c0[3]); \
    if ((i) == 8) pa[1] = perm4(c0[4], c0[5], c0[6], c0[7]); \
    if ((i) == 12) pa[2] = perm4(c1[0], c1[1], c1[2], c1[3]); \
    if (NSLOT > 16 && (i) == 16) { s1 += f1[15]; c1[7] = cvtpk(f1[14], f1[15]); } \
    if (NSLOT > 16 && (i) == 17) pa[3] = perm4(c1[4], c1[5], c1[6], c1[7]); \
  } while (0)
#pragma unroll
  for (int d0 = 0; d0 < NS; ++d0) {
    bf16x8 nb0 = kb0, nb1 = kb1;
    if (d0 + 1 < NS) { nb0 = *(const LAS3 bf16x8*)(Kl + (d0 + 1) * KDSTR); nb1 = *(const LAS3 bf16x8*)(Kl + (d0 + 1) * KDSTR + 512); }
    bf16x8 q;
    if (d0 < QREG) q = qr[d0]; else q = *(const volatile LAS3 bf16x8*)(qls + (d0 - QREG) * 1024);
#ifdef FILL_FIRST
    FIN_SLOT(2 * d0); SBAR();
    if (SC && d0 == 0) n0 = __builtin_amdgcn_mfma_f32_32x32x16_bf16(kb0, q, negM, 0, 0, 0); else n0 = __builtin_amdgcn_mfma_f32_32x32x16_bf16(kb0, q, n0, 0, 0, 0);
    FIN_SLOT(2 * d0 + 1); SBAR();
    if (SC && d0 == 0) n1 = __builtin_amdgcn_mfma_f32_32x32x16_bf16(kb1, q, negM, 0, 0, 0); else n1 = __builtin_amdgcn_mfma_f32_32x32x16_bf16(kb1, q, n1, 0, 0, 0);
    SBAR();
#else
    if (SC && d0 == 0) n0 = __builtin_amdgcn_mfma_f32_32x32x16_bf16(kb0, q, negM, 0, 0, 0); else n0 = __builtin_amdgcn_mfma_f32_32x32x16_bf16(kb0, q, n0, 0, 0, 0);
    FIN_SLOT(2 * d0); SBAR();
    if (SC && d0 == 0) n1 = __builtin_amdgcn_mfma_f32_32x32x16_bf16(kb1, q, negM, 0, 0, 0); else n1 = __builtin_amdgcn_mfma_f32_32x32x16_bf16(kb1, q, n1, 0, 0, 0);
    FIN_SLOT(2 * d0 + 1); SBAR();
#endif
    kb0 = nb0; kb1 = nb1;
  }
#undef FIN_SLOT
  s16x4 vl[4], vh[4];
#pragma unroll
  for (int ks = 0; ks < 4; ++ks) { vl[ks] = trb(vb + v_rd_off<4>(0, ks, 0)); vh[ks] = trb(vb + v_rd_off<4>(0, ks, 1)); }
  if constexpr (NSLOT <= 16) { s1 += f1[15]; c1[7] = cvtpk(f1[14], f1[15]); pa[3] = perm4(c1[4], c1[5], c1[6], c1[7]); }
  { float ps = s0 + s1; auto rr = __builtin_amdgcn_permlane32_swap(__float_as_uint(ps), __float_as_uint(ps), false, false);
    ps = __uint_as_float(rr[0]) + __uint_as_float(rr[1]); l_reg = l_reg * alphaPrev + ps; }
  SBAR();
  float mA = 0.f, mB = 0.f, pmax = 0.f, mnC = 0.f; bool keep = true;
#define MX3(a, b, c) fmaxf(fmaxf((a), (b)), (c))
#define PART_SLOT(j) do { \
    if ((j) == 0) { mA = MX3(n0[0], n0[1], n0[2]); mA = MX3(mA, n0[3], n0[4]); mB = MX3(n1[0], n1[1], n1[2]); mB = MX3(mB, n1[3], n1[4]); } \
    if ((j) == 1) { mA = MX3(mA, n0[5], n0[6]); mA = MX3(mA, n0[7], n0[8]); mB = MX3(mB, n1[5], n1[6]); mB = MX3(mB, n1[7], n1[8]); } \
    if ((j) == 2) { mA = MX3(mA, n0[9], n0[10]); mA = MX3(mA, n0[11], n0[12]); mB = MX3(mB, n1[9], n1[10]); mB = MX3(mB, n1[11], n1[12]); } \
    if ((j) == 3) { mA = MX3(mA, n0[13], n0[14]); mB = MX3(mB, n1[13], n1[14]); pmax = fmaxf(MX3(mA, mB, n0[15]), n1[15]); } \
    if ((j) == 4) { auto rr = __builtin_amdgcn_permlane32_swap(__float_as_uint(pmax), __float_as_uint(pmax), false, false); \
                    pmax = fmaxf(__uint_as_float(rr[0]), __uint_as_float(rr[1])); keep = SC ? __all(pmax <= thr) : __all(pmax - m_reg <= thr); } \
    if (SC) {   \
      if ((j) == 5) { alpha = 1.f; mn = m_reg; \
        if (!keep) { const float dl_ = fmaxf(pmax, 0.f); n0 = n0 - dl_; n1 = n1 - dl_; alpha = __builtin_amdgcn_exp2f(-dl_); m_reg += dl_; mn = m_reg; \
                     _Pragma("unroll") for (int r_ = 0; r_ < 16; ++r_) negM[r_] = -m_reg; } } \
      if ((j) >= 6 && (j) <= 11) { n0[(2 * ((j) - 6)) & 15] = __builtin_amdgcn_exp2f(n0[(2 * ((j) - 6)) & 15]); n0[(2 * ((j) - 6) + 1) & 15] = __builtin_amdgcn_exp2f(n0[(2 * ((j) - 6) + 1) & 15]); } \
      if ((j) >= 12) { n0[(12 + ((j) - 12)) & 15] = __builtin_amdgcn_exp2f(n0[(12 + ((j) - 12)) & 15]); } \
    } else { \
    if ((j) == 5) { mn = keep ? m_reg : fmaxf(m_reg, pmax); alpha = __builtin_amdgcn_exp2f((m_reg - mn) * C); m_reg = mn; mnC = -mn * C; } \
    if ((j) >= 6 && (j) <= 9) { _Pragma("unroll") for (int r_ = 0; r_ < 4; ++r_) n0[(4 * ((j) - 6) + r_) & 15] = fmaf(n0[(4 * ((j) - 6) + r_) & 15], C, mnC); } \
    if ((j) >= 7 && (j) <= 9) { n0[((j) - 7) & 15] = __builtin_amdgcn_exp2f(n0[((j) - 7) & 15]); } \
    if ((j) >= 10 && (j) <= 14) { n0[(3 + 2 * ((j) - 10)) & 15] = __builtin_amdgcn_exp2f(n0[(3 + 2 * ((j) - 10)) & 15]); n0[(4 + 2 * ((j) - 10)) & 15] = __builtin_amdgcn_exp2f(n0[(4 + 2 * ((j) - 10)) & 15]); } \
    if ((j) == 15) { n0[13] = __builtin_amdgcn_exp2f(n0[13]); n0[14] = __builtin_amdgcn_exp2f(n0[14]); n0[15] = __builtin_amdgcn_exp2f(n0[15]); } \
    } \
    if ((j) >= 6) asm volatile("" : "+v"(n0));     \
  } while (0)
#define PKV(L, H) (bf16x8){L[0], L[1], L[2], L[3], H[0], H[1], H[2], H[3]}
#pragma unroll
  for (int d0 = 0; d0 < 4; ++d0)
#pragma unroll
    for (int ks = 0; ks < 4; ++ks) {
      o[d0] = __builtin_amdgcn_mfma_f32_32x32x16_bf16(pa[ks], PKV(vl[ks], vh[ks]), o[d0], 0, 0, 0);
      if (d0 < 3) { vl[ks] = trb(vb + v_rd_off<4>(d0 + 1, ks, 0)); vh[ks] = trb(vb + v_rd_off<4>(d0 + 1, ks, 1)); }
      PART_SLOT(4 * d0 + ks); hook(4 * d0 + ks); SBAR(); }
#undef PKV
#undef PART_SLOT
#undef MX3
  if constexpr (SC) { fC = 1.f; fM = 0.f; } else { fC = C; fM = mnC; }
}
#endif
template <int DK, int LDQ, int LDK, int LDV, int LDO, int SDEPTH, int QREG>
__device__ __forceinline__ void dense_unit(const bf16_t* __restrict__ Qb, const bf16_t* __restrict__ Kh, const bf16_t* __restrict__ Vh,
                                           const int nt, const int v_first, const int v_last, const float SCALE, bf16_t* __restrict__ Ob, float* __restrict__ part, LAS3 char* lds, const int wave_id) {
  constexpr int SHM_K = (DK / 16) * KDSTR, NKC = DK / 64, CPR = DK / 8;
  constexpr float THRN = 8.f;
#ifdef SRCC
#ifdef SRCC_ALL
  constexpr bool SC = true;
#else
  constexpr bool SC = (DK == 128);
#endif
#else
  constexpr bool SC = false;
#endif
  const float QC = SCALE * LOG2E; const float C = SC ? 1.f : SCALE * LOG2E, thr = SC ? THRN * LOG2E : THRN / SCALE;
  const int wid = wave_id;
  int lane = lane_id_asm();
  const int tid = wid * 64 + lane; int r32 = lane & 31, hi = lane >> 5;
  LAS3 char* V_lds = lds; LAS3 char* K_lds = lds + 2 * SHM_V;
  LAS3 float* ws = (LAS3 float*)(lds + 2 * SHM_V + 2 * SHM_K) + wid * 64; LAS3 float* li_l = ws; LAS3 float* al_l = ws + 32;
  float m_reg = -1e30f, l_reg = 0; f32x16 o[4] = {}; bf16x8 qr[QREG > 0 ? QREG : 1];
  constexpr int NQL = DK / 16 - QREG;
  LAS3 char* qls = lds + 2 * SHM_V + 2 * SHM_K + 2048 + wid * (NQL * 1024) + lane * 16;
  const bf16_t* Qw = Qb + (long)(wid * QBLK + r32) * LDQ + hi * 8;
#pragma unroll
  for (int d0 = 0; d0 < DK / 16; ++d0) { bf16x8 qv = *(const bf16x8*)(Qw + d0 * 16);
    if constexpr (SC)
    { const u32x4 qw = __builtin_bit_cast(u32x4, qv); u32x4 qo;
      qo.x = cvtpk(__uint_as_float(qw.x << 16) * QC, __uint_as_float(qw.x & 0xffff0000u) * QC); qo.y = cvtpk(__uint_as_float(qw.y << 16) * QC, __uint_as_float(qw.y & 0xffff0000u) * QC);
      qo.z = cvtpk(__uint_as_float(qw.z << 16) * QC, __uint_as_float(qw.z & 0xffff0000u) * QC); qo.w = cvtpk(__uint_as_float(qw.w << 16) * QC, __uint_as_float(qw.w & 0xffff0000u) * QC);
      qv = __builtin_bit_cast(bf16x8, qo); }
    if (d0 < QREG) qr[d0] = qv; else *(LAS3 bf16x8*)(qls + (d0 - QREG) * 1024) = qv; }
  const int sr = tid >> 4, sc = (tid & 15) * 8, vst0 = v_st<4>(sr, sc), vst1 = v_st<4>(32 + sr, sc);
  int krow[NKC], kcol[NKC], kst[NKC];
#pragma unroll
  for (int i = 0; i < NKC; ++i) { const int q = tid + 512 * i; krow[i] = q / CPR; kcol[i] = (q % CPR) * 8; kst[i] = kimg(krow[i], q % CPR); }
  int vb0 = (int)(uintptr_t)V_lds + v_rd_base(lane);
#ifdef HANDSCHED
  const LAS3 char* vbp = V_lds + v_rd_base(lane);
#endif
  const LAS3 char* Kl0 = K_lds + hi * KHSTR + r32 * 16;
  bf16x8 svs0[SDEPTH], svs1[SDEPTH], sks[SDEPTH][NKC];
#define SLOAD(i, k0) do { svs0[i] = *(const bf16x8*)(&Vh[(long)((k0) + sr) * LDV + sc]); svs1[i] = *(const bf16x8*)(&Vh[(long)((k0) + 32 + sr) * LDV + sc]); \
    _Pragma("unroll") for (int c_ = 0; c_ < NKC; ++c_) sks[i][c_] = *(const bf16x8*)(&Kh[(long)((k0) + krow[c_]) * LDK + kcol[c_]]); } while (0)
#define SWRITE(b, i) do { *(LAS3 bf16x8*)(V_lds + (b) * SHM_V + vst0) = svs0[i]; *(LAS3 bf16x8*)(V_lds + (b) * SHM_V + vst1) = svs1[i]; \
    _Pragma("unroll") for (int c_ = 0; c_ < NKC; ++c_) *(LAS3 bf16x8*)(K_lds + (b) * SHM_K + kst[c_]) = sks[i][c_]; } while (0)
#define SWAIT() do { if constexpr (SDEPTH == 2) { if constexpr (NKC == 2) asm volatile("s_waitcnt vmcnt(4)" ::: "memory"); else asm volatile("s_waitcnt vmcnt(5)" ::: "memory"); } \
    else asm volatile("s_waitcnt vmcnt(0)" ::: "memory"); } while (0)
#define RESC(a) do { if (__any((a) < 1.f)) { if (hi == 0) al_l[r32] = (a); asm volatile("s_waitcnt lgkmcnt(0)" ::: "memory"); \
    _Pragma("unroll") for (int d = 0; d < 4; ++d) _Pragma("unroll") for (int r = 0; r < 16; ++r) o[d][r] *= al_l[crow(r, hi)]; } } while (0)
  f32x16 pA0, pA1, pB0, pB1; float mnA, mnB, alA, alB; bf16x8 pa0, pa1, pa2, pa3; const int NT = nt;
  constexpr int SE = 0, SO = SDEPTH - 1;
#ifdef PRIO_YOUNG
  if (wid >= 4) __builtin_amdgcn_s_setprio(1);
#endif
#ifdef ONE_BAR
#define SLOADP(i, t) do { const int vt_ = ((t) < NT ? (t) : NT - 1) * KVBLK, kt_ = ((t) + 1 < NT ? (t) + 1 : NT - 1) * KVBLK; \
    svs0[i] = *(const bf16x8*)(&Vh[(long)(vt_ + sr) * LDV + sc]); svs1[i] = *(const bf16x8*)(&Vh[(long)(vt_ + 32 + sr) * LDV + sc]); \
    _Pragma("unroll") for (int c_ = 0; c_ < NKC; ++c_) sks[i][c_] = *(const bf16x8*)(&Kh[(long)(kt_ + krow[c_]) * LDK + kcol[c_]]); } while (0)
#define SWRITEV(vb, i) do { *(LAS3 bf16x8*)(V_lds + (vb) * SHM_V + vst0) = svs0[i]; *(LAS3 bf16x8*)(V_lds + (vb) * SHM_V + vst1) = svs1[i]; } while (0)
#define SWRITEK(kb, i) do { _Pragma("unroll") for (int c_ = 0; c_ < NKC; ++c_) *(LAS3 bf16x8*)(K_lds + (kb) * SHM_K + kst[c_]) = sks[i][c_]; } while (0)
#ifdef VDMA
  static_assert((DK == 128 && SDEPTH == 2) || (DK != 128 && SDEPTH == 1), "VDMA wait counts are written for these two staging depths");
  int vro; { const int kk_ = (wid >> 1) * 8 + ((lane >> 2) & 7), kq_ = (kk_ & ~0xC) | ((kk_ & 4) << 1) | ((kk_ & 8) >> 1); vro = kq_ * LDV + (2 * (wid & 1) + (lane >> 5)) * 32 + (lane & 3) * 8; }
#undef SLOADP
#undef SWRITEV
#define SLOADP(i, t) do { const int kt_ = ((t) + 1 < NT ? (t) + 1 : NT - 1) * KVBLK; \
    _Pragma("unroll") for (int c_ = 0; c_ < NKC; ++c_) sks[i][c_] = *(const bf16x8*)(&Kh[(long)(kt_ + krow[c_]) * LDK + kcol[c_]]); } while (0)
#define SWRITEV(vb, i) do { } while (0)
#define VDMA_ISSUE(vb, t) do { const bf16_t* vg_ = Vh + (long)((t) * KVBLK) * LDV + vro; \
    __builtin_amdgcn_global_load_lds((const unsigned*)vg_, (LAS3 unsigned*)(V_lds + (vb) * SHM_V + wid * 1024), 16, 0, 0); \
    __builtin_amdgcn_global_load_lds((const unsigned*)(vg_ + 32 * LDV), (LAS3 unsigned*)(V_lds + (vb) * SHM_V + 8192 + wid * 1024), 16, 0, 0); } while (0)
#define VMW(n) asm volatile("s_waitcnt vmcnt(" #n ")" ::: "memory")
#ifdef KDMA_A
  constexpr bool KD = (DK != 128);
#else
  constexpr bool KD = false;
#endif
#if 1
  const int kro = lane * LDK + wid * 8;
#define KDMA_ISSUE(kb, t) do { const bf16_t* kg_ = Kh + (long)((t) * KVBLK) * LDK + kro; \
    _Pragma("unroll") for (int i_ = 0; i_ < NKC; ++i_) __builtin_amdgcn_global_load_lds((const unsigned*)(kg_ + 64 * i_), (LAS3 unsigned*)(K_lds + (kb) * SHM_K + ((wid >> 1) + 4 * i_) * KDSTR + (wid & 1) * KHSTR), 16, 0, 0); } while (0)
#endif
#endif
#ifdef VDMA
  if constexpr (KD) { KDMA_ISSUE(0, 0); KDMA_ISSUE(1, 1); VDMA_ISSUE(0, 0); VMW(0);
    __syncthreads(); }
  else {
#pragma unroll
    for (int c_ = 0; c_ < NKC; ++c_) sks[SE][c_] = *(const bf16x8*)(&Kh[(long)krow[c_] * LDK + kcol[c_]]);
    asm volatile("s_waitcnt vmcnt(0)" ::: "memory"); SWRITEK(0, SE);
    VDMA_ISSUE(0, 0);
    SLOADP(SE, 0); if constexpr (SDEPTH == 2) SLOADP(SO, 1);
    __syncthreads();
    if constexpr (SDEPTH == 2) VMW(2); else VMW(0);
    SWRITEK(1, SE); SLOADP(SE, SDEPTH); SBAR(); }
#else
#pragma unroll
  for (int c_ = 0; c_ < NKC; ++c_) sks[SE][c_] = *(const bf16x8*)(&Kh[(long)krow[c_] * LDK + kcol[c_]]);
  asm volatile("s_waitcnt vmcnt(0)" ::: "memory"); SWRITEK(0, SE);
  SLOADP(SE, 0); if constexpr (SDEPTH == 2) SLOADP(SO, 1);
  __syncthreads();
  SWAIT(); SWRITEV(0, SE); SWRITEK(1, SE); SLOADP(SE, SDEPTH); SBAR();
#endif
  qkt<DK, QREG>(pA0, pA1, Kl0, qr, qls); partialSM(pA0, pA1, m_reg, mnA, alA, C, thr, v_first, hi);
  __syncthreads();
#ifdef HANDSCHED
  float fC = 1.f, fM = 0.f;
  f32x16 negM;
#pragma unroll
  for (int r_ = 0; r_ < 16; ++r_) negM[r_] = SC ? -m_reg : 0.f;
#endif
  for (int j = 1; j + 1 < NT; j += 2) {
#ifdef HANDSCHED
#ifdef VDMA
    if constexpr (KD) {
    KDMA_ISSUE(0, j + 1); VDMA_ISSUE(1, j);
    SBAR(); hs_step<DK, QREG, SC>(negM, pB0, pB1, Kl0 + SHM_K, qr, qls, pA0, pA1, alA, l_reg, o, vbp, m_reg, mnB, alB, C, thr, fC, fM,
                              [&](int g) __attribute__((always_inline)) { (void)g; });
    RESC(alB); VMW(0); __syncthreads();
    KDMA_ISSUE(1, j + 2); VDMA_ISSUE(0, j + 1);
    SBAR(); hs_step<DK, QREG, SC>(negM, pA0, pA1, Kl0, qr, qls, pB0, pB1, alB, l_reg, o, vbp + SHM_V, m_reg, mnA, alA, C, thr, fC, fM,
                              [&](int g) __attribute__((always_inline)) { (void)g; });
    RESC(alA); VMW(0); __syncthreads();
    } else {
    if constexpr (DK != 128) { VMW(0); SWRITEK(0, SO); VDMA_ISSUE(1, j); SLOADP(SO, j + SDEPTH); } else { VDMA_ISSUE(1, j); }
    SBAR(); hs_step<DK, QREG, SC>(negM, pB0, pB1, Kl0 + SHM_K, qr, qls, pA0, pA1, alA, l_reg, o, vbp, m_reg, mnB, alB, C, thr, fC, fM,
                              [&](int g) __attribute__((always_inline)) { (void)g; });
    if constexpr (DK == 128) { VMW(4); SWRITEK(0, SO); SLOADP(SO, j + SDEPTH); }
    RESC(alB); if constexpr (DK == 128) VMW(2); else VMW(3);
    __syncthreads();
    if constexpr (DK != 128) { VMW(0); SWRITEK(1, SE); VDMA_ISSUE(0, j + 1); SLOADP(SE, j + 1 + SDEPTH); } else { VDMA_ISSUE(0, j + 1); }
    SBAR(); hs_step<DK, QREG, SC>(negM, pA0, pA1, Kl0, qr, qls, pB0, pB1, alB, l_reg, o, vbp + SHM_V, m_reg, mnA, alA, C, thr, fC, fM,
                              [&](int g) __attribute__((always_inline)) { (void)g; });
    if constexpr (DK == 128) { VMW(4); SWRITEK(1, SE); SLOADP(SE, j + 1 + SDEPTH); }
    RESC(alA); if constexpr (DK == 128) VMW(2); else VMW(3);
    __syncthreads();
    }
#else
    if constexpr (DK != 128) { SWAIT(); SWRITEV(1, SO); SWRITEK(0, SO); SLOADP(SO, j + SDEPTH); }
    SBAR(); hs_step<DK, QREG, SC>(negM, pB0, pB1, Kl0 + SHM_K, qr, qls, pA0, pA1, alA, l_reg, o, vbp, m_reg, mnB, alB, C, thr, fC, fM,
                              [&](int g) __attribute__((always_inline)) { (void)g; });
    if constexpr (DK == 128) { SWAIT(); SWRITEV(1, SO); SWRITEK(0, SO); SLOADP(SO, j + SDEPTH); }
    RESC(alB); __syncthreads();
    if constexpr (DK != 128) { SWAIT(); SWRITEV(0, SE); SWRITEK(1, SE); SLOADP(SE, j + 1 + SDEPTH); }
    SBAR(); hs_step<DK, QREG, SC>(negM, pA0, pA1, Kl0, qr, qls, pB0, pB1, alB, l_reg, o, vbp + SHM_V, m_reg, mnA, alA, C, thr, fC, fM,
                              [&](int g) __attribute__((always_inline)) { (void)g; });
    if constexpr (DK == 128) { SWAIT(); SWRITEV(0, SE); SWRITEK(1, SE); SLOADP(SE, j + 1 + SDEPTH); }
    RESC(alA); __syncthreads();
#endif
#else
    SWAIT(); SWRITEV(1, SO); SWRITEK(0, SO); SLOADP(SO, j + SDEPTH);
    SBAR(); qkt<DK, QREG>(pB0, pB1, Kl0 + SHM_K, qr, qls);
    finishSM(pA0, pA1, alA, l_reg, pa0, pa1, pa2, pa3); interleave_qk_sm<DK / 8, (DK == 128 ? 5 : 4)>(); SBAR();
    pv_sm(o, vb0, pa0, pa1, pa2, pa3, pB0, pB1, m_reg, mnB, alB, C, thr);
    RESC(alB); __syncthreads();
    SWAIT(); SWRITEV(0, SE); SWRITEK(1, SE); SLOADP(SE, j + 1 + SDEPTH);
    SBAR(); qkt<DK, QREG>(pA0, pA1, Kl0, qr, qls);
    finishSM(pB0, pB1, alB, l_reg, pa0, pa1, pa2, pa3); interleave_qk_sm<DK / 8, (DK == 128 ? 5 : 4)>(); SBAR();
    pv_sm(o, vb0 + SHM_V, pa0, pa1, pa2, pa3, pA0, pA1, m_reg, mnA, alA, C, thr);
    RESC(alA); __syncthreads();
#endif
  }
#ifdef VDMA
  VDMA_ISSUE(1, NT - 1);
#else
  SWAIT(); SWRITEV(1, SO);
#endif
#ifdef HANDSCHED
  pA1 = pA1 * fC + fM;
#endif
#undef SLOADP
#undef SWRITEV
#undef SWRITEK
#ifdef VDMA
#undef VDMA_ISSUE
#undef VMW
#undef KDMA_ISSUE
#endif
#else
  SLOAD(SE, 0); asm volatile("s_waitcnt vmcnt(0)" ::: "memory"); SWRITE(0, SE); __syncthreads();
  qkt<DK, QREG>(pA0, pA1, Kl0, qr, qls); partialSM(pA0, pA1, m_reg, mnA, alA, C, thr, v_first, hi);
  SLOAD(SO, KVBLK); if constexpr (SDEPTH == 2) { if (2 < NT) SLOAD(SE, 2 * KVBLK); }
  SWAIT(); SWRITE(1, SO); __syncthreads();
  for (int j = 1; j + 1 < NT; j += 2) {
    SBAR(); qkt<DK, QREG>(pB0, pB1, Kl0 + SHM_K, qr, qls);
    finishSM(pA0, pA1, alA, l_reg, pa0, pa1, pa2, pa3); interleave_qk_sm<DK / 8, (DK == 128 ? 5 : 4)>(); SBAR();
    SLOAD(SO, (j + SDEPTH) * KVBLK); SBAR();
    pv_sm(o, vb0, pa0, pa1, pa2, pa3, pB0, pB1, m_reg, mnB, alB, C, thr);
    __syncthreads(); SWAIT(); SWRITE(0, SE);
    RESC(alB); __syncthreads();
    SBAR(); qkt<DK, QREG>(pA0, pA1, Kl0, qr, qls);
    finishSM(pB0, pB1, alB, l_reg, pa0, pa1, pa2, pa3); interleave_qk_sm<DK / 8, (DK == 128 ? 5 : 4)>(); SBAR();
    if (SDEPTH == 1 || j + 3 < NT) SLOAD(SE, (j + 1 + SDEPTH) * KVBLK); SBAR();
    pv_sm(o, vb0 + SHM_V, pa0, pa1, pa2, pa3, pA0, pA1, m_reg, mnA, alA, C, thr);
    __syncthreads(); SWAIT(); SWRITE(1, SO);
    RESC(alA); __syncthreads();
  }
#endif
  { const int l2 = lane_id_asm();
    lane = l2; r32 = l2 & 31; hi = l2 >> 5; vb0 = (int)(uintptr_t)V_lds + v_rd_base(l2); Kl0 = K_lds + hi * KHSTR + r32 * 16; }
  SBAR(); qkt<DK, QREG>(pB0, pB1, Kl0 + SHM_K, qr, qls);
  finishSM(pA0, pA1, alA, l_reg, pa0, pa1, pa2, pa3); SBAR();
  pv_d0(o, vb0, pa0, pa1, pa2, pa3); partialSM(pB0, pB1, m_reg, mnB, alB, C, thr, v_last, hi);
#if defined(VDMA) && defined(ONE_BAR)
  asm volatile("s_waitcnt vmcnt(0)" ::: "memory");
#endif
  __syncthreads(); RESC(alB);
  finishSM(pB0, pB1, alB, l_reg, pa0, pa1, pa2, pa3); SBAR();
  pv_d0(o, vb0 + SHM_V, pa0, pa1, pa2, pa3);
#ifdef PRIO_YOUNG
  __builtin_amdgcn_s_setprio(0);
#endif
  const int lane_e = lane, r32e = r32, hie = hi, wide = wid;
  if (part == nullptr) {
    if (hie == 0) li_l[r32e] = l_reg; asm volatile("s_waitcnt lgkmcnt(0)" ::: "memory");
    float rli[16];
#pragma unroll
    for (int r = 0; r < 16; ++r) rli[r] = __builtin_amdgcn_rcpf(li_l[crow(r, hie)]);
    bf16_t* Ow = Ob + (long)(wide * QBLK) * LDO;
#pragma unroll
    for (int r = 0; r < 16; ++r) { const int orow = crow(r, hie);
#pragma unroll
      for (int d0 = 0; d0 < 4; ++d0) Ow[(long)orow * LDO + d0 * 32 + r32e] = (bf16_t)(cvtpk(o[d0][r] * rli[r], 0.f) & 0xffffu); }
  } else {
    float* pw = part + (size_t)(wide * QBLK) * 132;
#pragma unroll
    for (int r = 0; r < 16; ++r) { const int orow = crow(r, hie);
#pragma unroll
      for (int d0 = 0; d0 < 4; ++d0) pw[orow * 132 + d0 * 32 + r32e] = o[d0][r]; }
    if (hie == 0) { pw[r32e * 132 + 128] = m_reg; pw[r32e * 132 + 129] = l_reg; }
  }
#undef SLOAD
#undef SWRITE
#undef SWAIT
#undef RESC
}

constexpr int WA_SLOT = 8192, WA_V0 = 7 * WA_SLOT, WA_WS = 14 * WA_SLOT, WA_LDS = WA_WS + 8 * 256;
__device__ __forceinline__ void wattn_unit(const bf16_t* __restrict__ QKV, bf16_t* __restrict__ O, const float* __restrict__ sink, const int g, const int i, LAS3 char* lds, const int wave_id) {
  const int wid = __builtin_amdgcn_readfirstlane(wave_id), lane = lane_id_asm(), tid = wid * 64 + lane, r32 = lane & 31, hi = lane >> 5;
  const int lrow = tid >> 3, c8 = tid & 7;
  bf16x8 kreg[7], vreg[7];
#pragma unroll
  for (int T = 0; T < 7; ++T) {
    int kr;
    if (T < 6) { kr = 128 * i - 128 + 64 * T + lrow; kr = kr < 0 ? 0 : (kr > SEQ - 1 ? SEQ - 1 : kr); }
    else { kr = SEQ + (lrow < 15 ? lrow : 15); }
    const bf16_t* p = QKV + (size_t)kr * C_QKV + 2048 + 64 * g + c8 * 8;
    kreg[T] = *(const bf16x8*)p; vreg[T] = *(const bf16x8*)(p + 256);
  }
  __syncthreads();
  const int kw = lrow * 128 + ((c8 ^ (lrow & 7)) << 4), vw = v_st<2>(lrow, c8 * 8);
#pragma unroll
  for (int T = 0; T < 7; ++T) { *(LAS3 bf16x8*)(lds + T * WA_SLOT + kw) = kreg[T]; *(LAS3 bf16x8*)(lds + WA_V0 + T * WA_SLOT + vw) = vreg[T]; }
  __syncthreads();
  const int hq = 8 * g + wid;
  LAS3 float* al_l = (LAS3 float*)(lds + WA_WS) + wid * 64; LAS3 float* li_l = al_l + 32;
  const float C2 = 0.125f * LOG2E;
  const float sink2 = sink[hq] * LOG2E;
  const int vbase = (int)(uintptr_t)(lds + WA_V0) + v_rd_base(lane);
#ifdef WFAST
  const float thrw = 8.f * LOG2E;
  for (int s = 0; s < 4; ++s) {
    const int q0 = 128 * i + 32 * s, q = q0 + r32;
    bf16x8 qr[4];
#pragma unroll
    for (int d0 = 0; d0 < 4; ++d0) { const bf16x8 qv = *(const bf16x8*)(QKV + (size_t)q * C_QKV + 64 * hq + d0 * 16 + hi * 8);
      const u32x4 qw = __builtin_bit_cast(u32x4, qv); u32x4 qo;
      qo.x = cvtpk(__uint_as_float(qw.x << 16) * C2, __uint_as_float(qw.x & 0xffff0000u) * C2); qo.y = cvtpk(__uint_as_float(qw.y << 16) * C2, __uint_as_float(qw.y & 0xffff0000u) * C2);
      qo.z = cvtpk(__uint_as_float(qw.z << 16) * C2, __uint_as_float(qw.z & 0xffff0000u) * C2); qo.w = cvtpk(__uint_as_float(qw.w << 16) * C2, __uint_as_float(qw.w & 0xffff0000u) * C2);
      qr[d0] = __builtin_bit_cast(bf16x8, qo); }
    float m2 = sink2, l = 1.0f; f32x16 o[2] = {}; f32x16 negM;
#pragma unroll
    for (int r = 0; r < 16; ++r) negM[r] = -m2;
    const int Tlo = s >> 1;
    for (int tt = 0; tt < 6; ++tt) {
      const int T = (tt < 5) ? Tlo + tt : 6;
      const LAS3 char* Ks = lds + T * WA_SLOT;
      f32x16 p0, p1;
#pragma unroll
      for (int d0 = 0; d0 < 4; ++d0) { const int cb = d0 * 2 + hi;
        const bf16x8 b0 = *(const LAS3 bf16x8*)(Ks + r32 * 128 + ((cb ^ (r32 & 7)) << 4));
        const bf16x8 b1 = *(const LAS3 bf16x8*)(Ks + (32 + r32) * 128 + ((cb ^ (r32 & 7)) << 4));
        if (d0 == 0) { p0 = __builtin_amdgcn_mfma_f32_32x32x16_bf16(b0, qr[d0], negM, 0, 0, 0); p1 = __builtin_amdgcn_mfma_f32_32x32x16_bf16(b1, qr[d0], negM, 0, 0, 0); }
        else { p0 = __builtin_amdgcn_mfma_f32_32x32x16_bf16(b0, qr[d0], p0, 0, 0, 0); p1 = __builtin_amdgcn_mfma_f32_32x32x16_bf16(b1, qr[d0], p1, 0, 0, 0); } }
      const int kbase = 128 * i - 128 + 64 * T, off = kbase - q0;
      if (T == 6) {
#pragma unroll
        for (int r = 0; r < 16; ++r) { p0[r] = crow(r, hi) < N_META ? p0[r] : -1e30f; p1[r] = -1e30f; }
      } else if (kbase < 0 || kbase + 63 >= SEQ) {
#pragma unroll
        for (int r = 0; r < 16; ++r) { const int kg0 = kbase + crow(r, hi), kg1 = kg0 + 32;
          p0[r] = (((unsigned)kg0 < (unsigned)SEQ) && ((unsigned)(kg0 - q + 128) <= 256u)) ? p0[r] : -1e30f;
          p1[r] = (((unsigned)kg1 < (unsigned)SEQ) && ((unsigned)(kg1 - q + 128) <= 256u)) ? p1[r] : -1e30f; }
      } else if (off < -97) {
        const int bb = off - r32 + 128 + 4 * hi;
#pragma unroll
        for (int r = 0; r < 16; ++r) { const int cr = (r & 3) + 8 * (r >> 2); p0[r] = (bb + cr >= 0) ? p0[r] : -1e30f; p1[r] = (bb + cr + 32 >= 0) ? p1[r] : -1e30f; }
      } else if (off > 65) {
        const int bb = off - r32 - 128 + 4 * hi;
#pragma unroll
        for (int r = 0; r < 16; ++r) { const int cr = (r & 3) + 8 * (r >> 2); p0[r] = (bb + cr <= 0) ? p0[r] : -1e30f; p1[r] = (bb + cr + 32 <= 0) ? p1[r] : -1e30f; }
      }
      float tmax = fmaxf(p0[0], p1[0]);
#pragma unroll
      for (int r = 1; r < 16; ++r) tmax = fmaxf(tmax, fmaxf(p0[r], p1[r]));
      { auto rr = __builtin_amdgcn_permlane32_swap(__float_as_uint(tmax), __float_as_uint(tmax), false, false);
        tmax = fmaxf(__uint_as_float(rr[0]), __uint_as_float(rr[1])); }
      float alpha = 1.f;
      if (!__all(tmax <= thrw)) {
        const float dl = fmaxf(tmax, 0.f); p0 = p0 - dl; p1 = p1 - dl; alpha = __builtin_amdgcn_exp2f(-dl); m2 += dl;
#pragma unroll
        for (int r = 0; r < 16; ++r) negM[r] = -m2;
        if (hi == 0) al_l[r32] = alpha; asm volatile("s_waitcnt lgkmcnt(0)" ::: "memory");
#pragma unroll
        for (int d = 0; d < 2; ++d)
#pragma unroll
          for (int r = 0; r < 16; ++r) o[d][r] *= al_l[crow(r, hi)];
      }
      float ps = 0.f;
#pragma unroll
      for (int r = 0; r < 16; ++r) { p0[r] = __builtin_amdgcn_exp2f(p0[r]); p1[r] = __builtin_amdgcn_exp2f(p1[r]); ps += p0[r] + p1[r]; }
      { auto rr = __builtin_amdgcn_permlane32_swap(__float_as_uint(ps), __float_as_uint(ps), false, false);
        ps = __uint_as_float(rr[0]) + __uint_as_float(rr[1]); }
      l = l * alpha + ps;
      bf16x8 pa0, pa1, pa2, pa3; packP(p0, p1, pa0, pa1, pa2, pa3);
      const int vb = vbase + T * WA_SLOT;
      pv_one<2, 0>(o[0], vb, pa0, pa1, pa2, pa3); pv_one<2, 1>(o[1], vb, pa0, pa1, pa2, pa3);
    }
#else
  for (int s = 0; s < 4; ++s) {
    const int q0 = 128 * i + 32 * s, q = q0 + r32;
    bf16x8 qr[4];
#pragma unroll
    for (int d0 = 0; d0 < 4; ++d0) qr[d0] = *(const bf16x8*)(QKV + (size_t)q * C_QKV + 64 * hq + d0 * 16 + hi * 8);
    float m2 = sink2, l = 1.0f; f32x16 o[2] = {};
    const int Tlo = s >> 1;
    for (int tt = 0; tt < 6; ++tt) {
      const int T = (tt < 5) ? Tlo + tt : 6;
      const LAS3 char* Ks = lds + T * WA_SLOT;
      f32x16 p0 = f32x16{}, p1 = f32x16{};
#pragma unroll
      for (int d0 = 0; d0 < 4; ++d0) { const int cb = d0 * 2 + hi;
        const bf16x8 b0 = *(const LAS3 bf16x8*)(Ks + r32 * 128 + ((cb ^ (r32 & 7)) << 4));
        const bf16x8 b1 = *(const LAS3 bf16x8*)(Ks + (32 + r32) * 128 + ((cb ^ (r32 & 7)) << 4));
        p0 = __builtin_amdgcn_mfma_f32_32x32x16_bf16(b0, qr[d0], p0, 0, 0, 0);
        p1 = __builtin_amdgcn_mfma_f32_32x32x16_bf16(b1, qr[d0], p1, 0, 0, 0); }
      const int kbase = 128 * i - 128 + 64 * T, off = kbase - q0;
      const bool need_mask = (T == 6) || off < -97 || off > 65 || kbase < 0 || kbase + 63 >= SEQ;
      if (need_mask) {
#pragma unroll
        for (int r = 0; r < 16; ++r) {
          const int kl = crow(r, hi);
          bool v0, v1;
          if (T < 6) { const int kg0 = kbase + kl, kg1 = kg0 + 32;
            v0 = ((unsigned)kg0 < (unsigned)SEQ) && ((unsigned)(kg0 - q + 128) <= 256u);
            v1 = ((unsigned)kg1 < (unsigned)SEQ) && ((unsigned)(kg1 - q + 128) <= 256u); }
          else { v0 = kl < N_META; v1 = false; }
          p0[r] = v0 ? p0[r] : -1e30f; p1[r] = v1 ? p1[r] : -1e30f;
        }
      }
      float tmax = fmaxf(p0[0], p1[0]);
#pragma unroll
      for (int r = 1; r < 16; ++r) tmax = fmaxf(tmax, fmaxf(p0[r], p1[r]));
      { auto rr = __builtin_amdgcn_permlane32_swap(__float_as_uint(tmax), __float_as_uint(tmax), false, false);
        tmax = fmaxf(__uint_as_float(rr[0]), __uint_as_float(rr[1])); }
      const float mnew = fmaxf(m2, tmax * C2), alpha = __builtin_amdgcn_exp2f(m2 - mnew);
      const bool grew = __any(mnew > m2); m2 = mnew;
      float ps = 0.f;
#pragma unroll
      for (int r = 0; r < 16; ++r) { p0[r] = __builtin_amdgcn_exp2f(fmaf(p0[r], C2, -mnew)); p1[r] = __builtin_amdgcn_exp2f(fmaf(p1[r], C2, -mnew)); ps += p0[r] + p1[r]; }
      { auto rr = __builtin_amdgcn_permlane32_swap(__float_as_uint(ps), __float_as_uint(ps), false, false);
        ps = __uint_as_float(rr[0]) + __uint_as_float(rr[1]); }
      l = l * alpha + ps;
      if (grew) {
        if (hi == 0) al_l[r32] = alpha; asm volatile("s_waitcnt lgkmcnt(0)" ::: "memory");
#pragma unroll
        for (int d = 0; d < 2; ++d)
#pragma unroll
          for (int r = 0; r < 16; ++r) o[d][r] *= al_l[crow(r, hi)];
      }
      bf16x8 pa0, pa1, pa2, pa3; packP(p0, p1, pa0, pa1, pa2, pa3);
      const int vb = vbase + T * WA_SLOT;
      pv_one<2, 0>(o[0], vb, pa0, pa1, pa2, pa3); pv_one<2, 1>(o[1], vb, pa0, pa1, pa2, pa3);
    }
#endif
    if (hi == 0) li_l[r32] = l; asm volatile("s_waitcnt lgkmcnt(0)" ::: "memory");
#pragma unroll
    for (int r = 0; r < 16; ++r) { const int orow = crow(r, hi); const float rl = __builtin_amdgcn_rcpf(li_l[orow]);
#pragma unroll
      for (int d0 = 0; d0 < 2; ++d0) O[(size_t)(q0 + orow) * D_MODEL + 64 * hq + d0 * 32 + r32] = (bf16_t)(cvtpk(o[d0][r] * rl, 0.f) & 0xffffu); }
  }
}
#undef SBAR
}
#define GAS __attribute__((address_space(1)))
#define LAS __attribute__((address_space(3)))
typedef GAS unsigned gu32;
#define RLX_AGENT __ATOMIC_RELAXED, __HIP_MEMORY_SCOPE_AGENT
#define LDS_WAIT() asm volatile("s_waitcnt lgkmcnt(0)" ::: "memory")
#define XB_TMO      128
#define XB_XCNT(j)  (256  + 64 * (j))
#define XB_XSUB(j)  (1280 + 64 * (j))
#define XB_XGEN(j)  (2304 + 64 * (j))
#define XB_TOP      3328
#define XB_TOPGEN   3392
#define XCD_BAR_WORDS 3456
#define XB_SPIN_CAP (1u << 18)

__device__ __forceinline__ unsigned xb_ld(unsigned* p)              { return __hip_atomic_load(p, __ATOMIC_RELAXED, __HIP_MEMORY_SCOPE_AGENT); }
__device__ __forceinline__ unsigned xb_add(unsigned* p, unsigned v) { return __hip_atomic_fetch_add(p, v, __ATOMIC_RELAXED, __HIP_MEMORY_SCOPE_AGENT); }
__device__ __forceinline__ unsigned xb_xcc_id() { return (unsigned)__builtin_amdgcn_s_getreg((3 << 11) | 20) & 0xFu; }
#define XB_SPIN(cond, bar) do { unsigned _sp = 0; while (cond) { __builtin_amdgcn_s_sleep(1); \
    if ((++_sp & 255u) == 0u) { if (xb_ld(&(bar)[XB_TMO])) break; if (_sp > XB_SPIN_CAP) { atomicAdd(&(bar)[XB_TMO], 1u); break; } } } } while (0)

struct XcdBarrier {
    unsigned* bar; unsigned x;
    volatile LAS unsigned* st;
};

__device__ __forceinline__ XcdBarrier xcd_barrier_post(unsigned* bar, volatile LAS unsigned* st, const bool t0  ) {
    XcdBarrier b; b.bar = bar; b.x = xb_xcc_id(); b.st = st;
    if (t0) (void)xb_add(&bar[XB_XCNT(b.x)], 1u);
    return b;
}
__device__ __forceinline__ void xcd_barrier_complete(unsigned* bar, unsigned x, unsigned& nloc, unsigned& nx) {
    const unsigned G = gridDim.x * gridDim.y * gridDim.z;
    unsigned sum, cnt, mine, sp = 0u;
    for (;;) {
        sum = 0u; cnt = 0u; mine = 0u;
#pragma unroll
        for (unsigned j = 0; j < 16; ++j) { const unsigned c = xb_ld(&bar[XB_XCNT(j)]); sum += c; cnt += (c > 0u) ? 1u : 0u; mine = (j == x) ? c : mine; }
        if (sum == G) break;
        __builtin_amdgcn_s_sleep(1);
        if ((++sp & 255u) == 0u) { if (xb_ld(&bar[XB_TMO])) break; if (sp > XB_SPIN_CAP) { atomicAdd(&bar[XB_TMO], 1u); break; } }
    }
    nloc = mine > 0u ? mine : 1u; nx = cnt > 0u ? cnt : 1u;
}

__device__ __forceinline__ void xcd_barrier(const XcdBarrier& b, const bool t0  ) {
    asm volatile("s_waitcnt vmcnt(0)" ::: "memory");
    __syncthreads();
    if (t0) {
        unsigned* bar = b.bar;
        __builtin_amdgcn_s_waitcnt(0);
        unsigned nloc = b.st[0], nx = b.st[1];
        if (nloc == 0u) { xcd_barrier_complete(bar, b.x, nloc, nx); b.st[0] = nloc; b.st[1] = nx; }
        const unsigned old = xb_add(&bar[XB_XSUB(b.x)], 1u);
        const unsigned gen = old / nloc;
        if (old + 1u == (gen + 1u) * nloc) {
            __builtin_amdgcn_fence(__ATOMIC_RELEASE, "agent");
            asm volatile("s_waitcnt vmcnt(0)" ::: "memory");
            const unsigned og = xb_add(&bar[XB_TOP], 1u);
            const unsigned tg = og / nx;
            if (og + 1u == (tg + 1u) * nx) xb_add(&bar[XB_TOPGEN], 1u);
            else XB_SPIN(xb_ld(&bar[XB_TOPGEN]) == tg, bar);
            __builtin_amdgcn_fence(__ATOMIC_ACQUIRE, "agent");
            xb_add(&bar[XB_XGEN(b.x)], 1u);
            asm volatile("s_waitcnt vmcnt(0)" ::: "memory");
        } else {
            XB_SPIN(xb_ld(&bar[XB_XGEN(b.x)]) == gen, bar);
            __builtin_amdgcn_fence(__ATOMIC_ACQUIRE, "agent");
            asm volatile("s_waitcnt vmcnt(0)" ::: "memory");
        }
    }
    __syncthreads();
}
constexpr int NWAVES = 8;
constexpr size_t MiB = 1u << 20, KiB = 1u << 10;
constexpr size_t WS_CTL = 0, CTL_ZERO_BYTES = 1 * MiB;
constexpr size_t TAB32 = 2304 * KiB;
constexpr size_t WS_AC = 1 * MiB, WS_AS = WS_AC + TAB32, WS_ROWC = WS_AS + TAB32, WS_ROWS = WS_ROWC + TAB32, WS_COLC = WS_ROWS + TAB32, WS_COLS = WS_COLC + TAB32;
constexpr size_t WS_CC = WS_COLS + TAB32, WS_CS = WS_CC + 768 * KiB, WS_TABEND = WS_CS + 768 * KiB;
static_assert((size_t)MPAD * 32 * 4 <= TAB32 && (size_t)MPAD * 8 * 4 <= 768 * KiB && WS_TABEND <= 16 * MiB, "tables");
constexpr size_t WS_BIASP = 16 * MiB, WS_BLKE = WS_BIASP + 64 * KiB, WS_WGBASE = WS_BLKE + 64 * KiB, WS_TOKINFO = 16 * MiB + 256 * KiB, WS_TOKDEST = 17 * MiB, WS_PART = 17 * MiB + 512 * KiB;
static_assert(WS_TOKINFO + (size_t)SEQ * 32 <= WS_TOKDEST && WS_TOKDEST + (size_t)SEQ * 16 <= WS_PART && WS_PART + (size_t)256 * 16 * 132 * 4 <= 20 * MiB, "small buffers");
constexpr size_t WS_W_IN = 20 * MiB, WS_W_QB = WS_W_IN + 10 * MiB, WS_W_KVB = WS_W_QB + 1536 * KiB, WS_W_OUT = WS_W_KVB + 1 * MiB, WS_W_GU = WS_W_OUT + 8 * MiB,
                 WS_W_DN = WS_W_GU + 56 * MiB, WS_W_QKV = WS_W_DN + 28 * MiB, WS_W_CO = WS_W_QKV + 10 * MiB, WS_W_MGU = WS_W_CO + 8 * MiB, WS_W_MDN = WS_W_MGU + 448 * MiB, WS_W_END = WS_W_MDN + 224 * MiB;
static_assert(WS_W_END <= 816 * MiB, "weights");
constexpr size_t WS_H = 816 * MiB, WS_A = 946 * MiB;
constexpr size_t WS_Z = 1011 * MiB, WS_CQN = 1093 * MiB, WS_CKVN = 1110 * MiB, WS_QA = 1119 * MiB, WS_KA = 1168 * MiB, WS_VA = 1217 * MiB, WS_QB = 1250 * MiB, WS_KB = 1283 * MiB;
constexpr size_t WS_O = 1292 * MiB, WS_Y = 1357 * MiB, WS_ACT = 1487 * MiB;
constexpr size_t WS_QKV = WS_Z;
constexpr size_t WS_XS = 1011 * MiB, WS_Y2 = 1147 * MiB, WS_ACT2 = 1283 * MiB, WS_VB = 1760 * MiB, WS_YP = 1770 * MiB, WS_END = 1786 * MiB;
static_assert(WS_Z + (size_t)MPAD * ZLD * 2 <= WS_CQN && WS_CQN + (size_t)MPAD * 512 * 2 <= WS_CKVN && WS_CKVN + (size_t)MPAD * 256 * 2 <= WS_QA && WS_QA + (size_t)MPAD * QA_LD * 2 <= WS_KA &&
              WS_KA + (size_t)MPAD * QA_LD * 2 <= WS_VA && WS_VA + (size_t)MPAD * VA_LD * 2 <= WS_QB && WS_QB + (size_t)MPAD * QB_LD * 2 <= WS_KB && WS_KB + (size_t)MPAD * KB_LD * 2 <= WS_O &&
              WS_O + (size_t)MPAD * 2048 * 2 <= WS_Y && WS_Y + (size_t)MPAD * 2048 * 4 <= WS_ACT && WS_ACT + (size_t)MPAD * D_FF * 2 <= WS_VB && WS_VB + (size_t)MPAD * KB_LD * 2 <= WS_YP && WS_YP + (size_t)8 * 256 * 2048 * 4 <= WS_END && WS_H + (size_t)MPAD * 2048 * 4 <= WS_A &&
              WS_A + (size_t)MPAD * 2048 * 2 <= WS_Z && WS_XS + (size_t)MOE_ROWS * 2048 * 2 <= WS_Y2 && WS_Y2 + (size_t)MOE_ROWS * 2048 * 2 <= WS_ACT2 && WS_ACT2 + (size_t)MOE_ROWS * D_FF * 2 <= WS_VB, "d_ws map");
constexpr int CW_BAR = 4096, CW_CNT = 8192, CW_NBLK = CW_CNT + 64 * 8;
constexpr int RING_BYTES = 143360, LDSCTL_OFF = RING_BYTES, MISC_OFF = LDSCTL_OFF + 320, LDS_BYTES = 147456;
static_assert(att::WA_LDS <= RING_BYTES, "wattn LDS");

__device__ __forceinline__ float wave_sum(float v) {
#pragma unroll
    for (int o = 1; o < 64; o <<= 1) v += __shfl_xor(v, o);
    return v;
}
struct Ctx { LAS unsigned char* lds; int tid, lane, wave, vcu, G; };

enum { TM_PLAIN = 0, TM_QB = 1, TM_GATE = 2, TM_UP = 3, TM_QKV = 4 };
template <int MODE> __device__ __forceinline__ int tr_dest_row(int n) {
    if (MODE == TM_QB)   { const int h = n / 192, d = n % 192; if (d < 128) return n; const int j = d - 128; return h * 192 + 128 + 2 * (j & 31) + (j >> 5); }
    if (MODE == TM_GATE) { return 256 * (n >> 7) + (n & 127); }
    if (MODE == TM_UP)   { return 256 * (n >> 7) + 128 + (n & 127); }
    if (MODE == TM_QKV)  { const int hd = n >> 6, d = n & 63; if (hd < 36 && d < 16) return hd * 64 + 2 * (d & 7) + (d >> 3); return n; }
    return n;
}
template <int MODE, bool TILED = false, bool FP8 = false> __device__ __forceinline__ void transpose_item(const float* __restrict__ W, int K, int N, bf16_t* __restrict__ WT, LAS float* scr, int item, int lane, float wscale = 1.f) {
    const int nblk = N >> 5, kb = item / nblk, nb = item - kb * nblk, k0 = 64 * kb, n0 = 32 * nb;
    const int n4 = (lane & 7) * 4, kk = lane >> 3;
    f32x4 v[8];
#pragma unroll
    for (int it = 0; it < 8; ++it) v[it] = __builtin_nontemporal_load((const f32x4*)(W + (size_t)(k0 + 8 * it + kk) * N + n0 + n4));
#pragma unroll
    for (int it = 0; it < 8; ++it) { const int k = 8 * it + kk;
        scr[(n4 + 0) * 65 + k] = v[it][0]; scr[(n4 + 1) * 65 + k] = v[it][1]; scr[(n4 + 2) * 65 + k] = v[it][2]; scr[(n4 + 3) * 65 + k] = v[it][3]; }
    LDS_WAIT(); asm volatile("" ::: "memory");
    const int c = lane & 7;
#pragma unroll
    for (int j = 0; j < 4; ++j) { const int n = (lane >> 3) + 8 * j; const LAS float* s = scr + n * 65 + 8 * c;
        const int dr = tr_dest_row<MODE>(n0 + n);
        if constexpr (FP8) {
            u32x2 o; o.x = pkf8x4(s[0] * wscale, s[1] * wscale, s[2] * wscale, s[3] * wscale); o.y = pkf8x4(s[4] * wscale, s[5] * wscale, s[6] * wscale, s[7] * wscale);
            unsigned char* p = (unsigned char*)WT + ((size_t)(dr >> 8) * (K >> 7) + (k0 >> 7)) * 32768 + (dr & 255) * 128 + (k0 & 127) + 8 * c;
            __builtin_nontemporal_store(o, (u32x2*)p);
        } else {
        u32x4 o; o.x = pkbf(s[0], s[1]); o.y = pkbf(s[2], s[3]); o.z = pkbf(s[4], s[5]); o.w = pkbf(s[6], s[7]);
        bf16_t* p = TILED ? WT + ((size_t)(dr >> 8) * (K >> 6) + kb) * 16384 + (dr & 255) * 64 + 8 * c : WT + (size_t)dr * K + k0 + 8 * c;
        if (TILED || MODE == TM_GATE || MODE == TM_UP) __builtin_nontemporal_store(o, (u32x4*)p); else *(u32x4*)p = o; } }
    LDS_WAIT(); asm volatile("" ::: "memory");
}
__device__ __forceinline__ void tw_load(const float* __restrict__ W, int N, int item, int lane, f32x4 (&v)[16]) {
    const int nblk = N >> 5, kb = item / nblk, nb = item - kb * nblk, k0 = 128 * kb, n0 = 32 * nb;
    const int n4 = (lane & 7) * 4, kk = lane >> 3;
#pragma unroll
    for (int it = 0; it < 16; ++it) v[it] = __builtin_nontemporal_load((const f32x4*)(W + (size_t)(k0 + 16 * kk + it) * N + n0 + n4));
}
template <int MODE, bool TILED, bool FP8> __device__ __forceinline__ void tw_store(const f32x4 (&v)[16], int K, int N, bf16_t* __restrict__ WT, LAS float* scr, int item, int lane, float wscale = 1.f) {
    const int nblk = N >> 5, kb = item / nblk, nb = item - kb * nblk, k0 = 128 * kb, n0 = 32 * nb;
    const int n4 = (lane & 7) * 4, kk = lane >> 3;
    (void)scr;
#pragma unroll
    for (int i = 0; i < 4; ++i) {
        const int dr = tr_dest_row<MODE>(n0 + n4 + i);
        if constexpr (FP8) {
            u32x4 o; o.x = pkf8x4(v[0][i] * wscale, v[1][i] * wscale, v[2][i] * wscale, v[3][i] * wscale); o.y = pkf8x4(v[4][i] * wscale, v[5][i] * wscale, v[6][i] * wscale, v[7][i] * wscale);
            o.z = pkf8x4(v[8][i] * wscale, v[9][i] * wscale, v[10][i] * wscale, v[11][i] * wscale); o.w = pkf8x4(v[12][i] * wscale, v[13][i] * wscale, v[14][i] * wscale, v[15][i] * wscale);
            unsigned char* p = (unsigned char*)WT + ((size_t)(dr >> 8) * (K >> 7) + kb) * 32768 + (dr & 255) * 128 + 16 * kk;
            __builtin_nontemporal_store(o, (u32x4*)p);
        } else {
            u32x4 o0, o1; o0.x = pkbf(v[0][i], v[1][i]); o0.y = pkbf(v[2][i], v[3][i]); o0.z = pkbf(v[4][i], v[5][i]); o0.w = pkbf(v[6][i], v[7][i]);
            o1.x = pkbf(v[8][i], v[9][i]); o1.y = pkbf(v[10][i], v[11][i]); o1.z = pkbf(v[12][i], v[13][i]); o1.w = pkbf(v[14][i], v[15][i]);
            const int kq = k0 + 16 * kk;
            bf16_t* p = TILED ? WT + ((size_t)(dr >> 8) * (K >> 6) + (kq >> 6)) * 16384 + (dr & 255) * 64 + (kq & 63) : WT + (size_t)dr * K + kq;
            __builtin_nontemporal_store(o0, (u32x4*)p); __builtin_nontemporal_store(o1, (u32x4*)(p + 8)); }
    }
}
__device__ const float INVF_A[32] = {1.000000000e+00f, 6.636012793e-01f, 4.403665960e-01f, 2.922278047e-01f, 1.939227432e-01f, 1.286873668e-01f, 8.539710194e-02f, 5.666962266e-02f, 3.760603070e-02f, 2.495540865e-02f, 1.656043902e-02f, 1.098952908e-02f, 7.292664610e-03f, 4.839421250e-03f, 3.211445874e-03f, 2.131119603e-03f, 1.414213562e-03f, 9.384738514e-04f, 6.227723788e-04f, 4.132725589e-04f, 2.742481884e-04f, 1.819914323e-04f, 1.207697351e-04f, 8.014294872e-05f, 5.318296098e-05f, 3.529227615e-05f, 2.341999971e-05f, 1.554154005e-05f, 1.031338616e-05f, 6.843975370e-06f, 4.541670478e-06f, 3.013858077e-06f};
__device__ const float INVF_C[8] = {1.000000000e+00f, 1.939227432e-01f, 3.760603070e-02f, 7.292664610e-03f, 1.414213562e-03f, 2.742481884e-04f, 5.318296098e-05f, 1.031338616e-05f};
__device__ const float INVF_X[32] = {1.000000000e+00f, 7.498942614e-01f, 5.623413324e-01f, 4.216965139e-01f, 3.162277639e-01f, 2.371373773e-01f, 1.778279394e-01f, 1.333521307e-01f, 1.000000015e-01f, 7.498941571e-02f, 5.623413250e-02f, 4.216965288e-02f, 3.162277490e-02f, 2.371373773e-02f, 1.778279431e-02f, 1.333521493e-02f, 9.999999776e-03f, 7.498941850e-03f, 5.623413250e-03f, 4.216964822e-03f, 3.162277630e-03f, 2.371373586e-03f, 1.778279431e-03f, 1.333521446e-03f, 1.000000047e-03f, 7.498942432e-04f, 5.623413017e-04f, 4.216965172e-04f, 3.162277571e-04f, 2.371373703e-04f, 1.778279402e-04f, 1.333521504e-04f};
__device__ __forceinline__ void sincos_f32ang(float ang, float& s, float& c) {
    const double x = (double)ang;
    const double q = __builtin_rint(x * 0.63661977236758134308);
    double t = __builtin_fma(-q, 1.57079632679489655800e+00, x);
    t = __builtin_fma(-q, 6.12323399573676603587e-17, t);
    const double t2 = t * t;
    const double sp = t * (1.0 + t2 * (-1.0 / 6.0 + t2 * (1.0 / 120.0 + t2 * (-1.0 / 5040.0 + t2 * (1.0 / 362880.0 + t2 * (-1.0 / 39916800.0 + t2 * (1.0 / 6227020800.0)))))));
    const double cp = 1.0 + t2 * (-0.5 + t2 * (1.0 / 24.0 + t2 * (-1.0 / 720.0 + t2 * (1.0 / 40320.0 + t2 * (-1.0 / 3628800.0 + t2 * (1.0 / 479001600.0 + t2 * (-1.0 / 87178291200.0)))))));
    const int qi = (int)q & 3;
    const double sv = (qi == 0) ? sp : (qi == 1) ? cp : (qi == 2) ? -sp : -cp;
    const double cv = (qi == 0) ? cp : (qi == 1) ? -sp : (qi == 2) ? -cp : sp;
    s = (float)sv; c = (float)cv;
}
__device__ __forceinline__ int tok_pos(int r) { return r < SEQ ? r + N_META : (r < L_TOK ? r - SEQ : 0); }

struct Args { const float* in[30]; float* out; unsigned char* ws; int ph_lo, ph_hi; };
typedef __attribute__((address_space(4))) const unsigned long long karg_u64;
__device__ __forceinline__ unsigned long long karg_load(int idx) { asm volatile("" : "+s"(idx)); return ((karg_u64*)__builtin_amdgcn_kernarg_segment_ptr())[idx]; }
__device__ __forceinline__ const float* in_ptr(const Args&, int i) { return (const float*)(GAS const float*)karg_load(i); }
__device__ __forceinline__ unsigned char* ws_ptr(const Args&) { return (unsigned char*)(GAS unsigned char*)karg_load(31); }
static_assert(offsetof(Args, in) == 0 && offsetof(Args, out) == 240 && offsetof(Args, ws) == 248, "Args layout vs karg_load");
enum { I_X = 0, I_META, I_EATTN_PRE, I_EATTN_POST, I_W_IN, I_AQN, I_WQB, I_AKVN, I_WKVB, I_BQN, I_BKN, I_EW_OUT, I_EFFN_PRE, I_EFFN_POST, I_FG, I_FU, I_FD,
       I_OATTN_PRE, I_OATTN_POST, I_CWQKV, I_CBQKV, I_CSINK, I_CWOUT, I_CBOUT, I_OFFN_PRE, I_OFFN_POST, I_ROUTER, I_MG, I_MU, I_MD };

constexpr int CVT_NITEMS = 9 * (2 * 16 * 224 + 56 * 64), CVT_RX1 = 118 * 16, CVT_RX11 = 126 * 40;
__device__ __forceinline__ void cvt_big(const Ctx& F, const Args& a, const int lo, const int hi, const int worker, const int nworkers) {
    unsigned char* ws = ws_ptr(a);
    LAS float* scr = nullptr;
    const int gw = worker * NWAVES + F.wave, NGW = nworkers * NWAVES;
    constexpr int IT_FF = 16 * 224, IT_DN = 56 * 64;
    const int NITEMS = hi;
#define CVT_DECODE(it_, kind_, e_, r_) do { int q_ = (it_); kind_ = 0; e_ = 0; \
        if (q_ >= IT_FF) { q_ -= IT_FF; kind_ = 1; if (q_ >= IT_FF) { q_ -= IT_FF; kind_ = 2; if (q_ >= IT_DN) { q_ -= IT_DN; kind_ = 3; if (q_ >= 8 * IT_FF) { q_ -= 8 * IT_FF; kind_ = 4; if (q_ >= 8 * IT_FF) { q_ -= 8 * IT_FF; kind_ = 5; } } \
            if (kind_ == 5) { e_ = q_ / IT_DN; q_ -= e_ * IT_DN; } else { e_ = q_ / IT_FF; q_ -= e_ * IT_FF; } } } } r_ = q_; } while (0)
#define CVT_LOAD(kind_, e_, r_, v_) do { \
        const float* w_ = kind_ == 0 ? in_ptr(a, I_FG) : kind_ == 1 ? in_ptr(a, I_FU) : kind_ == 2 ? in_ptr(a, I_FD) : kind_ == 3 ? in_ptr(a, I_MG) + (size_t)e_ * 2048 * D_FF : kind_ == 4 ? in_ptr(a, I_MU) + (size_t)e_ * 2048 * D_FF : in_ptr(a, I_MD) + (size_t)e_ * D_FF * 2048; \
        tw_load(w_, (kind_ == 2 || kind_ == 5) ? 2048 : D_FF, r_, lane, v_); } while (0)
#define CVT_STORE(kind_, e_, r_, v_) do { \
        if (kind_ == 0) tw_store<TM_GATE, false, false>(v_, 2048, D_FF, (bf16_t*)(ws + WS_W_GU), scr, r_, lane); \
        else if (kind_ == 1) tw_store<TM_UP, false, false>(v_, 2048, D_FF, (bf16_t*)(ws + WS_W_GU), scr, r_, lane); \
        else if (kind_ == 2) tw_store<TM_PLAIN, true, false>(v_, D_FF, 2048, (bf16_t*)(ws + WS_W_DN), scr, r_, lane); \
        else if (kind_ == 3) tw_store<TM_GATE, true, true>(v_, 2048, D_FF, (bf16_t*)(ws + WS_W_MGU + (size_t)e_ * 2 * D_FF * 2048), scr, r_, lane, SC_WGU); \
        else if (kind_ == 4) tw_store<TM_UP, true, true>(v_, 2048, D_FF, (bf16_t*)(ws + WS_W_MGU + (size_t)e_ * 2 * D_FF * 2048), scr, r_, lane, SC_WGU); \
        else tw_store<TM_PLAIN, true, true>(v_, D_FF, 2048, (bf16_t*)(ws + WS_W_MDN + (size_t)e_ * 2048 * D_FF), scr, r_, lane, SC_WDN); } while (0)
    const int lane = F.lane;
    f32x4 va[16], vb[16];
    int it = lo + gw, ka = 0, ea = 0, ra = 0, kb_ = 0, eb = 0, rb = 0;
    if (it < NITEMS) { CVT_DECODE(it, ka, ea, ra); CVT_LOAD(ka, ea, ra, va); }
    while (it < NITEMS) {
        int nx = it + NGW;
        if (nx < NITEMS) { CVT_DECODE(nx, kb_, eb, rb); CVT_LOAD(kb_, eb, rb, vb); }
        CVT_STORE(ka, ea, ra, va);
        it = nx; if (it >= NITEMS) break;
        nx = it + NGW;
        if (nx < NITEMS) { CVT_DECODE(nx, ka, ea, ra); CVT_LOAD(ka, ea, ra, va); }
        CVT_STORE(kb_, eb, rb, vb);
        it = nx;
    }
#undef CVT_DECODE
#undef CVT_LOAD
#undef CVT_STORE
}
__device__ __forceinline__ void cvt_small(const Ctx& F, const Args& a, const int worker, const int nworkers) {
    unsigned char* ws = ws_ptr(a);
    LAS float* scr = (LAS float*)(F.lds + F.wave * 8448);
    const int gw = worker * NWAVES + F.wave, NGW = nworkers * NWAVES;
    constexpr int IT_QB = 8 * 48, IT_KVB = 4 * 64, IT_OUT = 32 * 64, IT_QKV = 32 * 80;
    constexpr int NITEMS = IT_QB + IT_KVB + IT_OUT + IT_QKV + IT_OUT;
    for (int it = gw; it < NITEMS; it += NGW) {
        int r = it;
        if (r < IT_QB)  { transpose_item<TM_QB>(in_ptr(a, I_WQB), 512, 1536, (bf16_t*)(ws + WS_W_QB), scr, r, F.lane); continue; } r -= IT_QB;
        if (r < IT_KVB) { transpose_item<TM_PLAIN>(in_ptr(a, I_WKVB), 256, 2048, (bf16_t*)(ws + WS_W_KVB), scr, r, F.lane); continue; } r -= IT_KVB;
        if (r < IT_OUT) { transpose_item<TM_PLAIN>(in_ptr(a, I_EW_OUT), 2048, 2048, (bf16_t*)(ws + WS_W_OUT), scr, r, F.lane); continue; } r -= IT_OUT;
        if (r < IT_QKV) { transpose_item<TM_QKV>(in_ptr(a, I_CWQKV), 2048, C_QKV, (bf16_t*)(ws + WS_W_QKV), scr, r, F.lane); continue; } r -= IT_QKV;
        transpose_item<TM_PLAIN>(in_ptr(a, I_CWOUT), 2048, 2048, (bf16_t*)(ws + WS_W_CO), scr, r, F.lane);
    }
}
__device__ __forceinline__ void p0_prologue(const Ctx& F, const Args& a) {
    unsigned char* ws = ws_ptr(a);
    LAS float* scr = (LAS float*)(F.lds + F.wave * 8448);
    const int gw = F.vcu * NWAVES + F.wave, NGW = F.G * NWAVES;
    constexpr int IT_IN = 32 * 74;
    for (int it = gw; it < IT_IN; it += NGW) transpose_item<TM_PLAIN>(in_ptr(a, I_W_IN), 2048, EVEN_IN, (bf16_t*)(ws + WS_W_IN), scr, it, F.lane);
    if (F.G != 256) cvt_small(F, a, F.vcu, F.G);
    const int gt = gw * 64 + F.lane, NGT = NGW * 64;
    { u32x4* zp = (u32x4*)((bf16_t*)(ws + WS_W_IN) + (size_t)EVEN_IN * 2048);
      for (int i = gt; i < 192 * 2048 / 8; i += NGT) zp[i] = (u32x4){0u, 0u, 0u, 0u}; }
    const float* gpre = in_ptr(a, I_EATTN_PRE);
    for (int m = gw; m < MPAD; m += NGW) {
        bf16_t* orow = (bf16_t*)(ws + WS_A) + (size_t)m * 2048;
        if (m >= L_TOK) {
#pragma unroll
            for (int j = 0; j < 4; ++j) *(u32x4*)(orow + 512 * j + 8 * F.lane) = (u32x4){0u, 0u, 0u, 0u};
            continue; }
        const float* src = m < SEQ ? in_ptr(a, I_X) + (size_t)m * 2048 : in_ptr(a, I_META) + (size_t)(m - SEQ) * 2048;
        f32x4 v[4][2]; float ss = 0.f;
#pragma unroll
        for (int j = 0; j < 4; ++j)
#pragma unroll
            for (int q = 0; q < 2; ++q) { v[j][q] = *(const f32x4*)(src + 512 * j + 8 * F.lane + 4 * q); ss += (v[j][q][0] * v[j][q][0] + v[j][q][1] * v[j][q][1]) + (v[j][q][2] * v[j][q][2] + v[j][q][3] * v[j][q][3]); }
        const float rs = rsqrtf(wave_sum(ss) * (1.0f / 2048.0f) + RMS_EPS);
#pragma unroll
        for (int j = 0; j < 4; ++j) { const f32x4 g0 = *(const f32x4*)(gpre + 512 * j + 8 * F.lane), g1 = *(const f32x4*)(gpre + 512 * j + 8 * F.lane + 4);
            const f32x4 x0 = v[j][0] * rs * g0, x1 = v[j][1] * rs * g1;
            u32x4 w; w.x = pkbf(x0[0], x0[1]); w.y = pkbf(x0[2], x0[3]); w.z = pkbf(x1[0], x1[1]); w.w = pkbf(x1[2], x1[3]);
            *(u32x4*)(orow + 512 * j + 8 * F.lane) = w; }
    }
    for (int idx = gt; idx < MPAD * 32; idx += NGT) {
        const int r = idx >> 5, i = idx & 31;
        const float invA = INVF_A[i], invX = INVF_X[i];
        const float angA = (float)tok_pos(r) * invA;
        const int grow = r < SEQ ? (r >> 6) : -1, gcol = r < SEQ ? (r & 63) : (r < L_TOK ? r - SEQ : 0);
        const float angR = (float)grow * invX, angC = (float)gcol * invX;
        float sn, cs;
        sincos_f32ang(angA, sn, cs); ((float*)(ws + WS_AC))[idx] = cs; ((float*)(ws + WS_AS))[idx] = sn;
        sincos_f32ang(angR, sn, cs); ((float*)(ws + WS_ROWC))[idx] = cs; ((float*)(ws + WS_ROWS))[idx] = sn;
        sincos_f32ang(angC, sn, cs); ((float*)(ws + WS_COLC))[idx] = cs; ((float*)(ws + WS_COLS))[idx] = sn;
    }
    for (int idx = gt; idx < MPAD * 8; idx += NGT) {
        const int r = idx >> 3, i = idx & 7;
        const float ang = (float)tok_pos(r) * INVF_C[i];
        float sn, cs; sincos_f32ang(ang, sn, cs);
        ((float*)(ws + WS_CC))[idx] = cs; ((float*)(ws + WS_CS))[idx] = sn;
    }
    for (int n = gt; n < C_QKV; n += NGT) ((float*)(ws + WS_BIASP))[tr_dest_row<TM_QKV>(n)] = in_ptr(a, I_CBQKV)[n];
}

__device__ __forceinline__ void p2_postz(const Ctx& F, const Args& a) {
    unsigned char* ws = ws_ptr(a);
    const int gw = F.vcu * NWAVES + F.wave, NGW = F.G * NWAVES, lane = F.lane;
    const bf16_t* Z = (const bf16_t*)(ws + WS_Z);
    bf16_t* CQN = (bf16_t*)(ws + WS_CQN); bf16_t* CKVN = (bf16_t*)(ws + WS_CKVN); bf16_t* KA = (bf16_t*)(ws + WS_KA); bf16_t* QB = (bf16_t*)(ws + WS_QB); bf16_t* KB = (bf16_t*)(ws + WS_KB); bf16_t* VB = (bf16_t*)(ws + WS_VB);
    const float* AC = (const float*)(ws + WS_AC); const float* AS = (const float*)(ws + WS_AS);
    const float* tc = (const float*)(ws + (lane < 32 ? WS_ROWC : WS_COLC)); const float* ts = (const float*)(ws + (lane < 32 ? WS_ROWS : WS_COLS));
    const int d1 = lane + (lane >= 32 ? 32 : 0), d2 = d1 + 32, ti = lane & 31;
    const f32x4 gq0 = *(const f32x4*)(in_ptr(a, I_AQN) + 8 * lane), gq1 = *(const f32x4*)(in_ptr(a, I_AQN) + 8 * lane + 4), gkv = *(const f32x4*)(in_ptr(a, I_AKVN) + 4 * lane);
    const float gbq1 = in_ptr(a, I_BQN)[d1], gbq2 = in_ptr(a, I_BQN)[d2], gbk1 = in_ptr(a, I_BKN)[d1], gbk2 = in_ptr(a, I_BKN)[d2];
    for (int row = gw; row < MPAD; row += NGW) {
        const bf16_t* z = Z + (size_t)row * ZLD; const int kr = kvrow(row);
        *(u32x2*)(VB + (size_t)kr * KB_LD + 4 * lane) = *(const u32x2*)(z + 2112 + 4 * lane);
        {
            const u32x4 w = *(const u32x4*)(z + 8 * lane);
            float x[8] = {bflo(w.x), bfhi(w.x), bflo(w.y), bfhi(w.y), bflo(w.z), bfhi(w.z), bflo(w.w), bfhi(w.w)};
            float ss = 0.f;
#pragma unroll
            for (int i = 0; i < 8; ++i) ss += x[i] * x[i];
            const float rs = rsqrtf(wave_sum(ss) * (1.0f / 512.0f) + RMS_EPS);
            u32x4 o; o.x = pkbf(x[0] * rs * gq0[0], x[1] * rs * gq0[1]); o.y = pkbf(x[2] * rs * gq0[2], x[3] * rs * gq0[3]);
            o.z = pkbf(x[4] * rs * gq1[0], x[5] * rs * gq1[1]); o.w = pkbf(x[6] * rs * gq1[2], x[7] * rs * gq1[3]);
            *(u32x4*)(CQN + (size_t)row * 512 + 8 * lane) = o;
        }
        {
            const u32x2 w = *(const u32x2*)(z + 512 + 4 * lane);
            const float x0 = bflo(w.x), x1 = bfhi(w.x), x2 = bflo(w.y), x3 = bfhi(w.y);
            const float rs = rsqrtf(wave_sum(x0 * x0 + x1 * x1 + x2 * x2 + x3 * x3) * (1.0f / 256.0f) + RMS_EPS);
            u32x2 o; o.x = pkbf(x0 * rs * gkv[0], x1 * rs * gkv[1]); o.y = pkbf(x2 * rs * gkv[2], x3 * rs * gkv[3]);
            *(u32x2*)(CKVN + (size_t)row * 256 + 4 * lane) = o;
        }
        if (lane < 32) {
            const float x1 = bf2f(z[768 + lane]), x2 = bf2f(z[800 + lane]);
            const float c = AC[(size_t)row * 32 + lane], s = AS[(size_t)row * 32 + lane];
            const unsigned pk = pkbf(x1 * c - x2 * s, x2 * c + x1 * s);
#pragma unroll
            for (int h = 0; h < 8; ++h) *(unsigned*)(KA + (size_t)kr * QA_LD + h * 192 + 128 + 2 * lane) = pk;
        }
        const float c = tc[(size_t)row * 32 + ti], s = ts[(size_t)row * 32 + ti];
#pragma unroll
        for (int h = 0; h < 10; ++h) {
            const bf16_t* zh = z + A_IN + 128 * h;
            float x1 = bf2f(zh[d1]), x2 = bf2f(zh[d2]);
            const float rs = rsqrtf(wave_sum(x1 * x1 + x2 * x2) * (1.0f / 128.0f) + RMS_EPS);
            x1 *= rs * (h < 8 ? gbq1 : gbk1); x2 *= rs * (h < 8 ? gbq2 : gbk2);
            const unsigned pk = pkbf(x1 * c - x2 * s, x2 * c + x1 * s);
            if (h < 8) *(unsigned*)(QB + (size_t)row * QB_LD + h * 128 + 2 * lane) = pk;
            else *(unsigned*)(KB + (size_t)kr * KB_LD + (h - 8) * 128 + 2 * lane) = pk;
        }
    }
}

template <bool SRC0, bool ROUTER, bool YSPLIT>
__device__ __forceinline__ void p_rownorm(const Ctx& F, const Args& a, const float* gpost, const float* gpre, const int nrows, float* dbg_out) {
    unsigned char* ws = ws_ptr(a);
    const int gw = F.vcu * NWAVES + F.wave, NGW = F.G * NWAVES, lane = F.lane;
    const bf16_t* Yb = (const bf16_t*)(ws + WS_Y); bf16_t* H = (bf16_t*)(ws + WS_H); bf16_t* A = (bf16_t*)(ws + WS_A);
    LAS f32x4* RL0 = (LAS f32x4*)(F.lds); LAS f32x4* RL1 = (LAS f32x4*)(F.lds + 32768);
    LAS unsigned* lcnt = (LAS unsigned*)(F.lds + 65536);
    if (ROUTER) {
        const float* R = in_ptr(a, I_ROUTER);
        for (int idx = F.tid; idx < 2048; idx += NWAVES * 64) {
            const int ln = idx & 63, q = idx >> 6, col = 8 * ln + 512 * (q >> 3) + (q & 7);
            RL0[q * 64 + ln] = *(const f32x4*)(R + (size_t)col * 8); RL1[q * 64 + ln] = *(const f32x4*)(R + (size_t)col * 8 + 4); }
        if (F.tid < 8) lcnt[F.tid] = 0u;
        __syncthreads();
    }
    for (int row = gw; row < nrows; row += NGW) {
        const bf16_t* yr = Yb + (size_t)row * 2048;
        const float* hb0 = row < SEQ ? in_ptr(a, I_X) + (size_t)row * 2048 : in_ptr(a, I_META) + (size_t)(row - SEQ) * 2048;
        f32x4 y[4][2], h[4][2]; float ss = 0.f;
#pragma unroll
        for (int j = 0; j < 4; ++j) {
            if (YSPLIT && row >= SEQ) {
#pragma unroll
                for (int q = 0; q < 2; ++q) { f32x4 s = (f32x4){0.f, 0.f, 0.f, 0.f};
#pragma unroll
                    for (int ks = 0; ks < 8; ++ks) s = s + *(const f32x4*)((const float*)(ws + WS_YP) + ((size_t)ks * 256 + (row - SEQ)) * 2048 + 512 * j + 8 * lane + 4 * q);
                    y[j][q] = s; }
            } else { const u32x4 w = *(const u32x4*)(yr + 512 * j + 8 * lane);
                y[j][0] = (f32x4){bflo(w.x), bfhi(w.x), bflo(w.y), bfhi(w.y)}; y[j][1] = (f32x4){bflo(w.z), bfhi(w.z), bflo(w.w), bfhi(w.w)}; }
            if (SRC0) { h[j][0] = *(const f32x4*)(hb0 + 512 * j + 8 * lane); h[j][1] = *(const f32x4*)(hb0 + 512 * j + 8 * lane + 4); }
            else { const u32x4 w = *(const u32x4*)(H + (size_t)row * 2048 + 512 * j + 8 * lane);
                h[j][0] = (f32x4){bflo(w.x), bfhi(w.x), bflo(w.y), bfhi(w.y)}; h[j][1] = (f32x4){bflo(w.z), bfhi(w.z), bflo(w.w), bfhi(w.w)}; }
#pragma unroll
            for (int q = 0; q < 2; ++q) ss += (y[j][q][0] * y[j][q][0] + y[j][q][1] * y[j][q][1]) + (y[j][q][2] * y[j][q][2] + y[j][q][3] * y[j][q][3]);
        }
        const float rs = rsqrtf(wave_sum(ss) * (1.0f / 2048.0f) + RMS_EPS);
        float ss2 = 0.f;
#pragma unroll
        for (int j = 0; j < 4; ++j) {
#pragma unroll
            for (int q = 0; q < 2; ++q) { const f32x4 g = *(const f32x4*)(gpost + 512 * j + 8 * lane + 4 * q);
                h[j][q] = h[j][q] + y[j][q] * rs * g;
                if (dbg_out && row < SEQ) *(f32x4*)(dbg_out + (size_t)row * 2048 + 512 * j + 8 * lane + 4 * q) = h[j][q];
                ss2 += (h[j][q][0] * h[j][q][0] + h[j][q][1] * h[j][q][1]) + (h[j][q][2] * h[j][q][2] + h[j][q][3] * h[j][q][3]); }
            u32x4 hw; hw.x = pkbf(h[j][0][0], h[j][0][1]); hw.y = pkbf(h[j][0][2], h[j][0][3]); hw.z = pkbf(h[j][1][0], h[j][1][1]); hw.w = pkbf(h[j][1][2], h[j][1][3]);
            *(u32x4*)(H + (size_t)row * 2048 + 512 * j + 8 * lane) = hw; }
        const float rs2 = rsqrtf(wave_sum(ss2) * (1.0f / 2048.0f) + RMS_EPS);
        float lg[8] = {0.f, 0.f, 0.f, 0.f, 0.f, 0.f, 0.f, 0.f};
#pragma unroll
        for (int j = 0; j < 4; ++j) {
            const f32x4 g0 = *(const f32x4*)(gpre + 512 * j + 8 * lane), g1 = *(const f32x4*)(gpre + 512 * j + 8 * lane + 4);
            const f32x4 x0 = h[j][0] * rs2 * g0, x1 = h[j][1] * rs2 * g1;
            u32x4 w; w.x = pkbf(x0[0], x0[1]); w.y = pkbf(x0[2], x0[3]); w.z = pkbf(x1[0], x1[1]); w.w = pkbf(x1[2], x1[3]);
            *(u32x4*)(A + (size_t)row * 2048 + 512 * j + 8 * lane) = w;
            if (ROUTER) {
#pragma unroll
                for (int i = 0; i < 8; ++i) { const float xv = i < 4 ? x0[i & 3] : x1[i & 3]; const f32x4 r0 = RL0[(j * 8 + i) * 64 + lane], r1 = RL1[(j * 8 + i) * 64 + lane];
                    lg[0] += xv * r0[0]; lg[1] += xv * r0[1]; lg[2] += xv * r0[2]; lg[3] += xv * r0[3]; lg[4] += xv * r1[0]; lg[5] += xv * r1[1]; lg[6] += xv * r1[2]; lg[7] += xv * r1[3]; }
            }
        }
        if (ROUTER) {
#pragma unroll
            for (int e = 0; e < 8; ++e) lg[e] = wave_sum(lg[e]);
            int e1 = 0; float v1 = lg[0];
#pragma unroll
            for (int e = 1; e < 8; ++e) if (lg[e] > v1) { v1 = lg[e]; e1 = e; }
            int e2 = -1; float v2 = -INFINITY;
#pragma unroll
            for (int e = 0; e < 8; ++e) if (e != e1 && lg[e] > v2) { v2 = lg[e]; e2 = e; }
            if (e2 < 0) e2 = (e1 + 1) & 7;
            const float g1 = 1.0f / (1.0f + __expf(v2 - v1)), g2 = 1.0f - g1;
            if (lane == 0) {
                const unsigned s1 = __hip_atomic_fetch_add(lcnt + e1, 1u, __ATOMIC_RELAXED, __HIP_MEMORY_SCOPE_WORKGROUP), s2 = __hip_atomic_fetch_add(lcnt + e2, 1u, __ATOMIC_RELAXED, __HIP_MEMORY_SCOPE_WORKGROUP);
                u32x4* ti = (u32x4*)(ws + WS_TOKINFO + (size_t)row * 32);
                ti[0] = (u32x4){(unsigned)e1, (unsigned)e2, s1, s2}; ti[1] = (u32x4){__float_as_uint(g1), __float_as_uint(g2), (unsigned)blockIdx.x, 0u};
            }
        }
    }
    if (ROUTER) {
        __syncthreads();
        if (F.tid < 8) { const unsigned base = __hip_atomic_fetch_add((unsigned*)(ws + WS_CTL) + CW_CNT + 64 * F.tid, lcnt[F.tid], RLX_AGENT);
            ((unsigned*)(ws + WS_WGBASE))[blockIdx.x * 8 + F.tid] = base; }
    }
}


__device__ __forceinline__ void p15_dispatch(const Ctx& F, const Args& a) {
    unsigned char* ws = ws_ptr(a);
    const int gw = F.vcu * NWAVES + F.wave, NGW = F.G * NWAVES, lane = F.lane;
    const unsigned* ctl = (const unsigned*)(ws + WS_CTL);
    unsigned pst[8]; unsigned acc = 0u;
#pragma unroll
    for (int e = 0; e < 8; ++e) { const unsigned c = __hip_atomic_load(ctl + CW_CNT + 64 * e, RLX_AGENT); pst[e] = acc; acc += (c + 255u) & ~255u; }
    if (blockIdx.x == 0 && F.tid == 0) {
        int* be = (int*)(ws + WS_BLKE);
#pragma unroll
        for (int e = 0; e < 8; ++e) { const unsigned b0 = pst[e] >> 8, b1 = (e < 7 ? pst[e < 7 ? e + 1 : 7] : acc) >> 8; for (unsigned b = b0; b < b1; ++b) be[b] = e; }
        *((unsigned*)(ws + WS_CTL) + CW_NBLK) = acc >> 8;
    }
    const bf16_t* A = (const bf16_t*)(ws + WS_A); unsigned char* XS8 = ws + WS_XS;
    const unsigned* wgb = (const unsigned*)(ws + WS_WGBASE);
    for (int row = gw; row < SEQ; row += NGW) {
        const u32x4* ti = (const u32x4*)(ws + WS_TOKINFO + (size_t)row * 32);
        const u32x4 i0 = ti[0], i1 = ti[1];
        const unsigned e1 = i0.x, e2 = i0.y, wg = i1.z;
        unsigned p1 = 0u, p2 = 0u;
#pragma unroll
        for (int e = 0; e < 8; ++e) { if ((unsigned)e == e1) p1 = pst[e]; if ((unsigned)e == e2) p2 = pst[e]; }
        const unsigned r1 = p1 + wgb[wg * 8 + e1] + i0.z, r2 = p2 + wgb[wg * 8 + e2] + i0.w;
#pragma unroll
        for (int j = 0; j < 4; ++j) { const u32x4 v = *(const u32x4*)(A + (size_t)row * 2048 + 512 * j + 8 * lane);
            u32x2 o; o.x = pkf8x4(bflo(v.x) * SC_X, bfhi(v.x) * SC_X, bflo(v.y) * SC_X, bfhi(v.y) * SC_X); o.y = pkf8x4(bflo(v.z) * SC_X, bfhi(v.z) * SC_X, bflo(v.w) * SC_X, bfhi(v.w) * SC_X);
            const size_t ko = (size_t)(4 * j + (lane >> 4)) * 32768 + (lane & 15) * 8;
            *(u32x2*)(XS8 + (size_t)(r1 >> 8) * (16 * 32768) + ko + (r1 & 255) * 128) = o; *(u32x2*)(XS8 + (size_t)(r2 >> 8) * (16 * 32768) + ko + (r2 & 255) * 128) = o; }
        if (lane == 0) *(u32x4*)(ws + WS_TOKDEST + (size_t)row * 16) = (u32x4){r1, r2, i1.x, i1.y};
    }
}

__device__ __forceinline__ void p18_final(const Ctx& F, const Args& a) {
    unsigned char* ws = ws_ptr(a);
    const int gw = F.vcu * NWAVES + F.wave, NGW = F.G * NWAVES, lane = F.lane;
    const bf16_t* Y2 = (const bf16_t*)(ws + WS_Y2); const bf16_t* H = (const bf16_t*)(ws + WS_H); const float* gpost = in_ptr(a, I_OFFN_POST);
    for (int row = gw; row < SEQ; row += NGW) {
        const u32x4 td = *(const u32x4*)(ws + WS_TOKDEST + (size_t)row * 16);
        const float g1 = __uint_as_float(td.z) * (1.0f / SC_Y), g2 = __uint_as_float(td.w) * (1.0f / SC_Y);
        float y[4][8]; float ss = 0.f;
        const unsigned char* Y8 = (const unsigned char*)Y2;
#pragma unroll
        for (int j = 0; j < 4; ++j) { const u32x2 wa = *(const u32x2*)(Y8 + (size_t)td.x * 2048 + 512 * j + 8 * lane), wb = *(const u32x2*)(Y8 + (size_t)td.y * 2048 + 512 * j + 8 * lane);
            typedef float f32x2v __attribute__((ext_vector_type(2)));
            const f32x2v a0 = __builtin_amdgcn_cvt_pk_f32_fp8((int)wa.x, false), a1 = __builtin_amdgcn_cvt_pk_f32_fp8((int)wa.x, true), a2 = __builtin_amdgcn_cvt_pk_f32_fp8((int)wa.y, false), a3 = __builtin_amdgcn_cvt_pk_f32_fp8((int)wa.y, true);
            const f32x2v b0 = __builtin_amdgcn_cvt_pk_f32_fp8((int)wb.x, false), b1 = __builtin_amdgcn_cvt_pk_f32_fp8((int)wb.x, true), b2 = __builtin_amdgcn_cvt_pk_f32_fp8((int)wb.y, false), b3 = __builtin_amdgcn_cvt_pk_f32_fp8((int)wb.y, true);
            y[j][0] = g1 * a0.x + g2 * b0.x; y[j][1] = g1 * a0.y + g2 * b0.y; y[j][2] = g1 * a1.x + g2 * b1.x; y[j][3] = g1 * a1.y + g2 * b1.y;
            y[j][4] = g1 * a2.x + g2 * b2.x; y[j][5] = g1 * a2.y + g2 * b2.y; y[j][6] = g1 * a3.x + g2 * b3.x; y[j][7] = g1 * a3.y + g2 * b3.y;
#pragma unroll
            for (int i = 0; i < 8; ++i) ss += y[j][i] * y[j][i]; }
        const float rs = rsqrtf(wave_sum(ss) * (1.0f / 2048.0f) + RMS_EPS);
#pragma unroll
        for (int j = 0; j < 4; ++j) { const u32x4 hw = *(const u32x4*)(H + (size_t)row * 2048 + 512 * j + 8 * lane);
            const float hvv[8] = {bflo(hw.x), bfhi(hw.x), bflo(hw.y), bfhi(hw.y), bflo(hw.z), bfhi(hw.z), bflo(hw.w), bfhi(hw.w)};
#pragma unroll
            for (int q = 0; q < 2; ++q) { const int col = 512 * j + 8 * lane + 4 * q; const f32x4 g = *(const f32x4*)(gpost + col);
                f32x4 o; o[0] = hvv[4 * q + 0] + y[j][4 * q + 0] * rs * g[0]; o[1] = hvv[4 * q + 1] + y[j][4 * q + 1] * rs * g[1]; o[2] = hvv[4 * q + 2] + y[j][4 * q + 2] * rs * g[2]; o[3] = hvv[4 * q + 3] + y[j][4 * q + 3] * rs * g[3];
                *(f32x4*)(a.out + (size_t)row * 2048 + col) = o; } }
    }
}
#ifndef DBG_STOP
#define DBG_STOP 0
#endif
#ifndef MK_PER_PHASE
#define MK_PER_PHASE 0
#endif
constexpr int N_PHASES = 19;
#ifndef DBG_LAST
#define DBG_LAST 18
#endif
constexpr int LAST_PHASE0 = (DBG_STOP == 1) ? 7 : (DBG_STOP == 2) ? 10 : (DBG_STOP == 3) ? 14 : 18;
constexpr int LAST_PHASE = LAST_PHASE0 < DBG_LAST ? LAST_PHASE0 : DBG_LAST;

__global__ void __launch_bounds__(NWAVES * 64, 2) enc_fwd(Args args) {
    extern __shared__ __attribute__((aligned(16))) unsigned char lds_raw[];
    Ctx F;
    F.lds = (LAS unsigned char*)lds_raw;
    volatile LAS unsigned* MISC = (volatile LAS unsigned*)(F.lds + MISC_OFF);
    F.wave = __builtin_amdgcn_readfirstlane((int)threadIdx.x >> 6); F.lane = lane_id_asm(); F.tid = F.wave * 64 + F.lane;
    F.G = gridDim.x; { const int bx = blockIdx.x; F.vcu = (F.G % 8 == 0) ? (bx % 8) * (F.G / 8) + bx / 8 : bx; }
    unsigned char* ws = ws_ptr(args);
    for (int u = F.tid; u < (LDS_BYTES - LDSCTL_OFF) / 4; u += NWAVES * 64) ((LAS unsigned*)(F.lds + LDSCTL_OFF))[u] = 0u;
    __syncthreads();
    XcdBarrier bar; bar.bar = (unsigned*)(ws + WS_CTL) + CW_BAR; bar.x = 0; bar.st = nullptr;
    if (!MK_PER_PHASE) bar = xcd_barrier_post((unsigned*)(ws + WS_CTL) + CW_BAR, MISC + 8, F.tid == 0);
    const int lo = args.ph_lo, hi = args.ph_hi;
#ifndef P16_WGM
#define P16_WGM 8
#endif
#ifndef P9_WGM
#define P9_WGM 8
#endif
#ifndef PH_MASK
#define PH_MASK 0x7FFFF
#endif
#define IN(k) ((((PH_MASK) >> (k)) & 1) && lo <= (k) && (k) < hi)
#define RETID() do { F.lane = lane_id_asm(); F.tid = F.wave * 64 + F.lane; ws = ws_ptr(args); A = (bf16_t*)(ws + WS_A); O = (bf16_t*)(ws + WS_O); Y = (float*)(ws + WS_Y); } while (0)
#define SEAM(k) do { if (!MK_PER_PHASE && IN(k) && IN((k) + 1)) { xcd_barrier(bar, (F.wave * 64 + lane_id_asm()) == 0); } RETID(); } while (0)
    bf16_t* A = (bf16_t*)(ws + WS_A);
    bf16_t* O = (bf16_t*)(ws + WS_O);
    float* Y = (float*)(ws + WS_Y);

     if (IN(0)) { p0_prologue(F, args); }  SEAM(0);
     if (IN(1)) {
        pg8::Gemm g{A, (const bf16_t*)(ws + WS_W_IN), MPAD, ZLD, 2048}; pg8::StaticOrder S; S.init(MPAD, ZLD, F.G, (int)blockIdx.x);
        pg8::EpiBf16<0> E{(bf16_t*)(ws + WS_Z), ZLD, nullptr, 0, 0, 1.f};
        pg8::gemm_phase<pg8::EpiBf16<0>, pg8::StaticOrder, true, true>(F.lds, g, S, E, F.wave);
        if ((int)blockIdx.x >= 138 && F.G == 256) {
            F.lane = lane_id_asm(); cvt_small(F, args, (int)blockIdx.x - 138, 118);
            cvt_big(F, args, CVT_NITEMS - CVT_RX1 - CVT_RX11, CVT_NITEMS - CVT_RX11, (int)blockIdx.x - 138, 118); }
    }  SEAM(1);
     if (IN(2)) { p2_postz(F, args); }  SEAM(2);
     if (IN(3)) {
        { pg8::Gemm g{(const bf16_t*)(ws + WS_CQN), (const bf16_t*)(ws + WS_W_QB), MPAD, 1536, 512}; pg8::StaticOrder S; S.init(MPAD, 1536, F.G, (int)blockIdx.x);
          EpiQA E{(bf16_t*)(ws + WS_QA), (const float*)(ws + WS_AC), (const float*)(ws + WS_AS)};
          pg8::gemm_phase<EpiQA, pg8::StaticOrder, true, true>(F.lds, g, S, E, F.wave); }
        { pg8::Gemm g{(const bf16_t*)(ws + WS_CKVN), (const bf16_t*)(ws + WS_W_KVB), MPAD, 2048, 256}; pg8::StaticOrder S; S.init(MPAD, 2048, F.G, (int)blockIdx.x);
          EpiKV E{(bf16_t*)(ws + WS_KA), (bf16_t*)(ws + WS_VA)};
          pg8::gemm_phase<EpiKV, pg8::StaticOrder, true, true>(F.lds, g, S, E, F.wave); }
    }  SEAM(3);
     if (IN(4)) {
        constexpr int NT_ALL = 258;
        const int slot = F.vcu % 3;
        int u = F.vcu;
        if (slot == 0) { F.lane = lane_id_asm(); cvt_big(F, args, 0, F.G == 256 ? CVT_NITEMS - CVT_RX1 - CVT_RX11 : CVT_NITEMS, F.vcu, F.G); __syncthreads(); }
        for (; u < 512; u += F.G) { unsigned char* w2 = ws_ptr(args); const int r = u & 511, h = (r & 255) >> 5, qb = (r & 31) + 32 * (r >> 8);
            att::dense_unit<192, QA_LD, QA_LD, VA_LD, 2048, 1, 12>((const bf16_t*)(w2 + WS_QA) + (size_t)qb * 256 * QA_LD + h * 192, (const bf16_t*)(w2 + WS_KA) + h * 192, (const bf16_t*)(w2 + WS_VA) + h * 128, NT_ALL, N_META, 0, 0.07216878364870322f,
                                                              (bf16_t*)(w2 + WS_O) + (size_t)qb * 256 * 2048 + h * 128, nullptr, (LAS char*)F.lds, F.wave); }
        if (slot == 1) { __syncthreads(); F.lane = lane_id_asm(); cvt_big(F, args, 0, F.G == 256 ? CVT_NITEMS - CVT_RX1 - CVT_RX11 : CVT_NITEMS, F.vcu, F.G); __syncthreads(); }
        for (; u < 1024; u += F.G) { unsigned char* w2 = ws_ptr(args); const int r = u & 511, h = (r & 255) >> 5, qb = (r & 31) + 32 * (r >> 8), kvh = h >> 2;
            att::dense_unit<128, QB_LD, KB_LD, KB_LD, 2048, 2, 8>((const bf16_t*)(w2 + WS_QB) + (size_t)qb * 256 * QB_LD + h * 128, (const bf16_t*)(w2 + WS_KB) + kvh * 128, (const bf16_t*)(w2 + WS_VB) + kvh * 128, NT_ALL, N_META, 0, 0.08838834764831845f,
                                                             (bf16_t*)(w2 + WS_O) + (size_t)qb * 256 * 2048 + 1024 + h * 128, nullptr, (LAS char*)F.lds, F.wave); }
        if (slot == 2) { __syncthreads(); F.lane = lane_id_asm(); cvt_big(F, args, 0, F.G == 256 ? CVT_NITEMS - CVT_RX1 - CVT_RX11 : CVT_NITEMS, F.vcu, F.G); __syncthreads(); }
        for (; u < 1280; u += F.G) { unsigned char* w2 = ws_ptr(args); const int r = u - 1024, hh = r >> 4, ch = r & 15, t0 = 16 * ch, nt = (ch == 15) ? NT_ALL - 240 : 16;
            float* part = (float*)(w2 + WS_ACT) + (size_t)r * 256 * 132;
            if (hh < 8) att::dense_unit<192, QA_LD, QA_LD, VA_LD, 2048, 1, 12>((const bf16_t*)(w2 + WS_QA) + (size_t)SEQ * QA_LD + hh * 192, (const bf16_t*)(w2 + WS_KA) + (size_t)t0 * 64 * QA_LD + hh * 192, (const bf16_t*)(w2 + WS_VA) + (size_t)t0 * 64 * VA_LD + hh * 128,
                                                                          nt, ch == 0 ? N_META : 64, ch == 15 ? 0 : 64, 0.07216878364870322f, nullptr, part, (LAS char*)F.lds, F.wave);
            else { const int h = hh - 8, kvh = h >> 2;
                att::dense_unit<128, QB_LD, KB_LD, KB_LD, 2048, 2, 8>((const bf16_t*)(w2 + WS_QB) + (size_t)SEQ * QB_LD + h * 128, (const bf16_t*)(w2 + WS_KB) + (size_t)t0 * 64 * KB_LD + kvh * 128, (const bf16_t*)(w2 + WS_VB) + (size_t)t0 * 64 * KB_LD + kvh * 128,
                                                                 nt, ch == 0 ? N_META : 64, ch == 15 ? 0 : 64, 0.08838834764831845f, nullptr, part, (LAS char*)F.lds, F.wave); } }
    }  SEAM(4);
     if (IN(5)) {
        const float* PART = (const float*)(ws + WS_ACT);
        for (int idx = blockIdx.x * (NWAVES * 64) + F.tid; idx < 16 * 16 * 128; idx += F.G * NWAVES * 64) {
            const int hh = idx >> 11, row = (idx >> 7) & 15, col = idx & 127;
#if defined(SRCC) && defined(SRCC_ALL)
            const float C = 1.f;
#elif defined(SRCC)
            const float C = hh < 8 ? 0.07216878364870322f * 1.4426950408889634f : 1.f;
#else
            const float C = (hh < 8 ? 0.07216878364870322f : 0.08838834764831845f) * 1.4426950408889634f;
#endif
            const float* p = PART + ((size_t)hh * 16 * 256 + row) * 132;
            float M = -1e30f;
#pragma unroll
            for (int c = 0; c < 16; ++c) M = fmaxf(M, p[(size_t)c * 256 * 132 + 128]);
            float num = 0.f, den = 0.f;
#pragma unroll
            for (int c = 0; c < 16; ++c) { const float* pc = p + (size_t)c * 256 * 132; const float w = __builtin_amdgcn_exp2f((pc[128] - M) * C); num += pc[col] * w; den += pc[129] * w; }
            O[(size_t)(SEQ + row) * 2048 + hh * 128 + col] = (bf16_t)(pkbf(num / den, 0.f) & 0xffffu);
        }
    }  SEAM(5);
     if (IN(6)) {
        pg8::Gemm g{O, (const bf16_t*)(ws + WS_W_OUT), MPAD, 2048, 2048}; MetaSplitOrder S; S.init(8, 2048, 8, F.G, (int)blockIdx.x);
        EpiYBf16 E{(bf16_t*)Y, 2048, nullptr, (float*)(ws + WS_YP), 256};
        pg8::gemm_phase<EpiYBf16, MetaSplitOrder, true, true>(F.lds, g, S, E, F.wave);
    }  SEAM(6);
     if (IN(7)) { p_rownorm<true, false, true>(F, args, in_ptr(args, I_EATTN_POST), in_ptr(args, I_EFFN_PRE), L_TOK, DBG_STOP == 1 ? args.out : nullptr); }  SEAM(7);
     if (IN(8)) {
        { pg8::Gemm g{A, (const bf16_t*)(ws + WS_W_GU), MPAD, 2 * D_FF, 2048}; MetaSplitOrder S; S.init(56, 2048, 4, F.G, (int)blockIdx.x);
          EpiSwiGLU E{(bf16_t*)(ws + WS_ACT), D_FF, 56, 1, (float*)(ws + WS_YP)};
          pg8::gemm_phase<EpiSwiGLU, MetaSplitOrder, true, true>(F.lds, g, S, E, F.wave); }
        xcd_barrier(bar, (F.wave * 64 + lane_id_asm()) == 0); RETID();
        { const float* SP = (const float*)(ws + WS_YP); bf16_t* ACT = (bf16_t*)(ws + WS_ACT);
          for (int idx = F.vcu * (NWAVES * 64) + F.wave * 64 + lane_id_asm(); idx < 56 * 16 * 32; idx += F.G * NWAVES * 64) {
              const int pn = idx >> 9, r = (idx >> 5) & 15, j4 = (idx & 31) * 4;
              f32x4 gg = (f32x4){0.f, 0.f, 0.f, 0.f}, uu = gg;
#pragma unroll
              for (int sl = 0; sl < 4; ++sl) { const float* q = SP + ((size_t)(sl * 56 + pn) * 16 + r) * 256 + j4; gg = gg + *(const f32x4*)q; uu = uu + *(const f32x4*)(q + 128); }
              const int col = pn * 128 + j4;
              u32x2 w; w.x = pkbf(silu_f(gg[0]) * uu[0], silu_f(gg[1]) * uu[1]); w.y = pkbf(silu_f(gg[2]) * uu[2], silu_f(gg[3]) * uu[3]);
              *(u32x2*)(ACT + ((size_t)(64 * (D_FF >> 6) + (col >> 6))) * 16384 + r * 64 + (col & 63)) = w; } }
    }  SEAM(8);
     if (IN(9)) {
        pg8::Gemm g{(const bf16_t*)(ws + WS_ACT), (const bf16_t*)(ws + WS_W_DN), MPAD, 2048, D_FF}; MetaSplitOrder S; S.init(8, D_FF, 8, F.G, (int)blockIdx.x, P9_WGM);
        EpiYBf16 E{(bf16_t*)Y, 2048, nullptr, (float*)(ws + WS_YP), D_FF / 8};
        pg8::gemm_phase<EpiYBf16, MetaSplitOrder, true, true, true>(F.lds, g, S, E, F.wave);
    }
#if defined(PROBE_P9)
    if (IN(9)) {
        __syncthreads();
        pg8::Gemm g{(const bf16_t*)(ws + WS_ACT), (const bf16_t*)(ws + WS_W_DN), MPAD, 2048, D_FF}; ProbeOrder S; S.S.init(8, D_FF, 8, F.G, (int)blockIdx.x); S.zpm = (PROBE_P9) & 1; S.zpn = ((PROBE_P9) >> 1) & 1;
        EpiF32 E{(float*)(ws + WS_XS), 2048, nullptr, (float*)(ws + WS_Y2), D_FF / 8};
        pg8::gemm_phase<EpiF32, ProbeOrder, true, true, true>(F.lds, g, S, E, F.wave);
    }
#endif
    SEAM(9);
     if (IN(10)) { p_rownorm<false, false, true>(F, args, in_ptr(args, I_EFFN_POST), in_ptr(args, I_OATTN_PRE), L_TOK, DBG_STOP == 2 ? args.out : nullptr); }  SEAM(10);
     if (IN(11)) {
        pg8::Gemm g{A, (const bf16_t*)(ws + WS_W_QKV), MPAD, C_QKV, 2048}; RowsPlusOrder S; S.init(64, 10, 8, F.G, (int)blockIdx.x);
        EpiQKV E{(bf16_t*)(ws + WS_QKV), (const float*)(ws + WS_BIASP), (const float*)(ws + WS_CC), (const float*)(ws + WS_CS)};
        pg8::gemm_phase<EpiQKV, RowsPlusOrder, true, true>(F.lds, g, S, E, F.wave);
        if ((int)blockIdx.x >= 130 && F.G == 256) {
            F.lane = lane_id_asm(); cvt_big(F, args, CVT_NITEMS - CVT_RX11, CVT_NITEMS, (int)blockIdx.x - 130, 126); }
    }  SEAM(11);
     if (IN(12)) {
        for (int u = F.vcu; u < 512; u += F.G) att::wattn_unit((const bf16_t*)(ws + WS_QKV), O, in_ptr(args, I_CSINK), u >> 7, u & 127, (LAS char*)F.lds, F.wave);
        __syncthreads();
    }  SEAM(12);
     if (IN(13)) {
        pg8::Gemm g{O, (const bf16_t*)(ws + WS_W_CO), SEQ, 2048, 2048}; pg8::StaticOrder S; S.init(SEQ, 2048, F.G, (int)blockIdx.x);
        EpiYBf16 E{(bf16_t*)Y, 2048, in_ptr(args, I_CBOUT), nullptr, 1};
        pg8::gemm_phase<EpiYBf16, pg8::StaticOrder, true, true>(F.lds, g, S, E, F.wave);
    }  SEAM(13);
     if (IN(14)) { p_rownorm<false, true, false>(F, args, in_ptr(args, I_OATTN_POST), in_ptr(args, I_OFFN_PRE), SEQ, DBG_STOP == 3 ? args.out : nullptr); }  SEAM(14);
     if (IN(15)) { p15_dispatch(F, args); }  SEAM(15);
     if (IN(16)) {
        const int nblk = (int)__hip_atomic_load((const unsigned*)(ws + WS_CTL) + CW_NBLK, RLX_AGENT);
        pg8::Gemm g{(const bf16_t*)(ws + WS_XS), (const bf16_t*)(ws + WS_W_MGU), nblk * 256, 2 * D_FF, 2048}; MoeOrder S; S.init(nblk, 56, F.G, (int)blockIdx.x, (const int*)(ws + WS_BLKE), P16_WGM);
        EpiSwiGLU8 E{ws + WS_ACT2, D_FF, 56, 1.0f / (SC_X * SC_WGU), SC_ACT};
        pg8::gemm_phase<EpiSwiGLU8, MoeOrder, true, true, true, true>(F.lds, g, S, E, F.wave);
    }  SEAM(16);
     if (IN(17)) {
        const int nblk = (int)__hip_atomic_load((const unsigned*)(ws + WS_CTL) + CW_NBLK, RLX_AGENT);
        { pg8::Gemm g{(const bf16_t*)(ws + WS_ACT2), (const bf16_t*)(ws + WS_W_MDN), nblk * 256, 2048, D_FF}; MoeTailOrder S; S.init(nblk, 8, D_FF, F.G, (int)blockIdx.x, (const int*)(ws + WS_BLKE));
          EpiMoeDown E{(bf16_t*)(ws + WS_Y2), 2048, 8, (float*)(ws + WS_XS), 1.0f / (SC_ACT * SC_WDN)};
          pg8::gemm_phase<EpiMoeDown, MoeTailOrder, true, true, true, true>(F.lds, g, S, E, F.wave); }
        const int U = nblk * 8, RG = (U / F.G) * F.G, Lf = U - RG, sp = MoeTailOrder::pick_s(Lf, F.G);
        if (sp > 1) {
            xcd_barrier(bar, (F.wave * 64 + lane_id_asm()) == 0); RETID();
            pg8::StaticOrder SM; SM.init(nblk * 256, 8 * 256, F.G, (int)blockIdx.x);
            const float* SP = (const float*)(ws + WS_XS); bf16_t* Y2 = (bf16_t*)(ws + WS_Y2);
            for (int idx = F.vcu * NWAVES + F.wave; idx < Lf * 256; idx += F.G * NWAVES) {
                const int j = idx >> 8, r = idx & 255; pg8::Unit u; SM.map(RG + j, u);
                f32x4 sacc = (f32x4){0.f, 0.f, 0.f, 0.f};
                for (int ks = 0; ks < sp; ++ks) sacc = sacc + *(const f32x4*)(SP + (size_t)(j * sp + ks) * 65536 + r * 256 + 4 * F.lane);
                *(unsigned*)((unsigned char*)Y2 + (size_t)(u.pm * 256 + r) * 2048 + u.pn * 256 + 4 * F.lane) = pkf8x4(sacc[0] * SC_Y, sacc[1] * SC_Y, sacc[2] * SC_Y, sacc[3] * SC_Y);
            }
        }
    }  SEAM(17);
     if (IN(18)) { p18_final(F, args); }
#undef IN
#undef SEAM
}

extern "C" void kernel_launch(void* const* d_in, const int* in_sizes, int n_in, void* d_out, int out_size, void* d_ws, size_t ws_size, hipStream_t stream) {
    static int grid = 0;
    if (grid == 0) {
        if (n_in != 30 || in_sizes[0] != SEQ * D_MODEL || out_size != SEQ * D_MODEL || ws_size < WS_END) {
            fprintf(stderr, "kernel_launch: shape mismatch: n_in %d in0 %d out %d ws %zu (need >= %zu); nothing launched\n", n_in, n_in > 0 ? in_sizes[0] : -1, out_size, ws_size, (size_t)WS_END); grid = -1; return; }
        int dev = 0, cus = 0, per_cu = 0;
        if (hipGetDevice(&dev) != hipSuccess || hipDeviceGetAttribute(&cus, hipDeviceAttributeMultiprocessorCount, dev) != hipSuccess) { grid = -1; return; }
        if (hipFuncSetAttribute((const void*)enc_fwd, hipFuncAttributeMaxDynamicSharedMemorySize, LDS_BYTES) != hipSuccess) { fprintf(stderr, "kernel_launch: hipFuncSetAttribute failed\n"); grid = -1; return; }
        if (hipOccupancyMaxActiveBlocksPerMultiprocessor(&per_cu, (const void*)enc_fwd, NWAVES * 64, LDS_BYTES) != hipSuccess || per_cu < 1)
            fprintf(stderr, "kernel_launch: occupancy query reports %d workgroups per CU\n", per_cu);
        (void)hipGetLastError();
        grid = cus;
    }
    if (grid < 0) return;
    if (hipMemsetAsync((char*)d_ws + WS_CTL, 0, CTL_ZERO_BYTES, stream) != hipSuccess) { fprintf(stderr, "kernel_launch: memset failed\n"); return; }
    Args a{};
    for (int i = 0; i < 30; ++i) a.in[i] = (const float*)d_in[i];
    a.out = (float*)d_out; a.ws = (unsigned char*)d_ws;
#if MK_PER_PHASE
    for (int p = 0; p <= LAST_PHASE; ++p) { a.ph_lo = p; a.ph_hi = p + 1; hipLaunchKernelGGL(enc_fwd, dim3(grid), dim3(NWAVES * 64), LDS_BYTES, stream, a); }
#else
    a.ph_lo = 0; a.ph_hi = LAST_PHASE + 1;
    hipLaunchKernelGGL(enc_fwd, dim3(grid), dim3(NWAVES * 64), LDS_BYTES, stream, a);
#endif
    const hipError_t le = hipPeekAtLastError();
    if (le != hipSuccess) fprintf(stderr, "kernel_launch: launch failed: %s\n", hipGetErrorName(le));
}
```

```cpp
#define ONE_BAR 1
#define HANDSCHED 1
#define VDMA 1
#define KDMA_A 1
#define SRCC 1
#define SRCC_ALL 1
#define WFAST 1
#include <hip/hip_runtime.h>
#include <cstdio>
#include <cstdint>
#include <cstddef>
__device__ __forceinline__ int lane_id_asm() { int l; asm volatile("v_mbcnt_lo_u32_b32 %0, -1, 0\n\tv_mbcnt_hi_u32_b32 %0, -1, %0" : "=&v"(l)); return l; }
namespace pg8 {
#define PG8_LAS __attribute__((address_space(3)))
typedef unsigned short bf16_t;
typedef short bf16x8 __attribute__((ext_vector_type(8)));
typedef float f32x4 __attribute__((ext_vector_type(4)));
typedef unsigned u32x4 __attribute__((ext_vector_type(4)));
typedef int i32x4 __attribute__((ext_vector_type(4)));
typedef int i32x8 __attribute__((ext_vector_type(8)));
constexpr int BM = 256, BK = 64, HALF = 128, HTB = HALF * BK * 2  , STAGE_BYTES = 8 * HTB, NXCD = 8, WGM = 8;

__host__ __device__ __forceinline__ int lds_byte(int r, int c) { const int st = (r >> 4) * 2 + (c >> 5), rr = r & 15, cc = c & 31, ob = rr * 64 + cc * 2; return st * 1024 + (ob ^ (((ob >> 9) & 1) << 5)); }
__host__ __device__ __forceinline__ void stage_rc(int b, int& R, int& C) { const int st = b / 1024, sb = b % 1024, swz = sb ^ (((sb >> 9) & 1) << 5); R = (st >> 1) * 16 + swz / 64; C = (st & 1) * 32 + (swz % 64) / 2; }
__host__ __device__ __forceinline__ int perm32(int rho) { const int n = rho >> 4, i = rho & 15; return 8 * (i >> 2) + 4 * n + (i & 3); }

struct Unit { int pm, pn, k0, nt; };
struct Gemm { const bf16_t* A; const bf16_t* Bt; int M, N, K; };

struct StaticOrder {
    int nM, nN, nwg, G, c, wgm;
    __host__ __device__ __forceinline__ void init(int M, int N, int G_, int c_, int wgm_ = WGM) { nM = M / BM; nN = N / BM; nwg = nM * nN; G = G_; c = c_; wgm = wgm_; }
    __host__ __device__ __forceinline__ bool next(int i, Unit& u) const { const long L = (long)i * G + c; if (L >= nwg) return false; map((int)L, u); return true; }
    __host__ __device__ __forceinline__ void map(int L, Unit& u) const {
        int wgid = L; { const int q = nwg / NXCD, r = nwg % NXCD, xcd = wgid % NXCD, off = wgid / NXCD; wgid = (xcd < r ? xcd * (q + 1) : r * (q + 1) + (xcd - r) * q) + off; }
        const int nig = wgm * nN, gid = wgid / nig, fm = gid * wgm, gsz = (nM - fm) < wgm ? (nM - fm) : wgm;
        u.pm = fm + ((wgid % nig) % gsz); u.pn = (wgid % nig) / gsz; u.k0 = 0; u.nt = 0;
    }
    __device__ __forceinline__ void a_ready(const Unit&) const {}
    __device__ __forceinline__ void done(const Unit&) const {}
};

__device__ __forceinline__ unsigned cvt_pk_bf16(float lo, float hi) { unsigned r; asm volatile("v_cvt_pk_bf16_f32 %0, %1, %2" : "=v"(r) : "v"(lo), "v"(hi)); return r; }
typedef float f32x2 __attribute__((ext_vector_type(2)));
__device__ __forceinline__ f32x2 gelu_pk(f32x2 v) {
    const f32x2 av = __builtin_elementwise_abs(v), d = av * 0.2316418882f + 1.0f;
    f32x2 t; t.x = __builtin_amdgcn_rcpf(d.x); t.y = __builtin_amdgcn_rcpf(d.y);
    f32x2 q = t * 0.5307027145f + (-0.7265760135f); q = q * t + 0.7107068705f; q = q * t + (-0.142248368f); q = q * t + 0.127414796f; q = q * t;
    const f32x2 s = (v * v) * (-0.72134752044f);
    f32x2 e; e.x = __builtin_amdgcn_exp2f(s.x); e.y = __builtin_amdgcn_exp2f(s.y);
    const f32x2 m = v * (q * e), r = v - m;
    f32x2 o; o.x = v.x < 0.f ? m.x : r.x; o.y = v.y < 0.f ? m.y : r.y; return o;
}

template <int ACT  > struct EpiBf16 {
    static constexpr bool PERM = true, AFTER_DRAIN = false; static_assert(ACT == 0 || ACT == 1, "EpiBf16: ACT is 0 (none) or 1 (gelu_pk)");
    bf16_t* O; int ldc; const float* bias; int split_cols; size_t split_stride; float scale0;
    __device__ __forceinline__ void operator()(const f32x4 (&acc)[2][2][4][2], const Unit& u, int wr, int wc, int fr, int fq) const {
        const int row0 = u.pm * BM + wr * 64 + fr; int colt = u.pn * BM; bf16_t* base = O;
        float sc = 1.f; if (split_cols) { const int t = colt / split_cols; base += (size_t)t * split_stride; colt -= t * split_cols; if (t == 0) sc = scale0; }
        const int col0 = colt + wc * 32 + 8 * fq, bcol0 = u.pn * BM + wc * 32 + 8 * fq;
        f32x4 bv[2][2];
#pragma unroll
        for (int bj = 0; bj < 2; ++bj)
#pragma unroll
            for (int n = 0; n < 2; ++n) bv[bj][n] = bias ? *(const f32x4*)(bias + bcol0 + bj * HALF + 4 * n) : (f32x4){0.f, 0.f, 0.f, 0.f};
#pragma unroll
        for (int ai = 0; ai < 2; ++ai)
#pragma unroll
            for (int m = 0; m < 4; ++m) { bf16_t* rowp = base + (size_t)(row0 + ai * HALF + m * 16) * ldc + col0;
#pragma unroll
                for (int bj = 0; bj < 2; ++bj) { f32x4 v0 = acc[ai][bj][m][0] + bv[bj][0], v1 = acc[ai][bj][m][1] + bv[bj][1];
                    if (ACT == 1) { f32x2 a = gelu_pk((f32x2){v0[0], v0[1]}), b = gelu_pk((f32x2){v0[2], v0[3]}), c = gelu_pk((f32x2){v1[0], v1[1]}), d = gelu_pk((f32x2){v1[2], v1[3]});
                        v0 = (f32x4){a.x, a.y, b.x, b.y}; v1 = (f32x4){c.x, c.y, d.x, d.y}; }
                    v0 = v0 * sc; v1 = v1 * sc; u32x4 w; w.x = cvt_pk_bf16(v0[0], v0[1]); w.y = cvt_pk_bf16(v0[2], v0[3]); w.z = cvt_pk_bf16(v1[0], v1[1]); w.w = cvt_pk_bf16(v1[2], v1[3]);
                    *(u32x4*)(rowp + bj * HALF) = w; } }
    }
};

template <class Epi, class Sched, bool ALIGN_EPI = false, bool SP2 = false, bool TILED = false, bool FP8 = false>
__device__ __forceinline__ void gemm_phase(PG8_LAS unsigned char* lds, const Gemm g, const Sched& S, const Epi& E, const int wave_id) {
    const int wid = __builtin_amdgcn_readfirstlane(wave_id), tid = wid * 64 + lane_id_asm(), lane = tid & 63, wr = wid >> 2, wc = wid & 3, fr = lane & 15, fq = lane >> 4;
    static_assert(!FP8 || (TILED && SP2), "FP8 operands: tiled layout, SP2 loop");
    constexpr int KEB = FP8 ? 256 : 512;
    const int K = g.K, nt = K / (FP8 ? 2 * BK : BK);
    unsigned voffA[2], voffB[2];
#pragma unroll
    for (int i = 0; i < 2; ++i) { int R, C; stage_rc(tid * 16 + i * 8192, R, C); const int Rb = Epi::PERM ? ((R & ~31) + perm32(R & 31)) : R;
        voffA[i] = TILED ? (unsigned)(R * 64 + C) * 2u : (unsigned)(R * K + C) * 2u; voffB[i] = TILED ? (unsigned)(Rb * 64 + C) * 2u : (unsigned)(Rb * K + C) * 2u; }
    const size_t kstep = TILED ? (size_t)32768 : (size_t)(BK * 2);
    const size_t hstep = TILED ? (size_t)16384 : (size_t)HALF * K * 2;
    const size_t tstep = TILED ? (size_t)K * KEB : 2 * hstep;
    const unsigned ldsw = (unsigned)wid * 1024u;
    const int aoff = lds_byte(wr * 64 + fr, fq * 8), boff = lds_byte(wc * 32 + fr, fq * 8);
#define PG8_SA(b, h) (((b) * 2 + (h)) * HTB)
#define PG8_SB(b, h) ((4 + (b) * 2 + (h)) * HTB)
#define PG8_STAGE(bufoff, gbase, voff) do { _Pragma("unroll") for (int _i = 0; _i < 2; ++_i) \
        __builtin_amdgcn_global_load_lds((const unsigned*)((const char*)(gbase) + (voff)[_i]), (PG8_LAS unsigned*)(lds + (bufoff) + ldsw + _i * 8192), 16, 0, 0); } while (0)
#define PG8_LDA(dst, b, h) do { _Pragma("unroll") for (int m = 0; m < 4; ++m) _Pragma("unroll") for (int k = 0; k < 2; ++k) dst[m][k] = *(const PG8_LAS bf16x8*)(lds + PG8_SA(b, h) + aoff + m * 2048 + k * 1024); } while (0)
#define PG8_LDB(dst, b, h) do { _Pragma("unroll") for (int n = 0; n < 2; ++n) _Pragma("unroll") for (int k = 0; k < 2; ++k) dst[n][k] = *(const PG8_LAS bf16x8*)(lds + PG8_SB(b, h) + boff + n * 2048 + k * 1024); } while (0)
#define PG8_CAT8(x, y) __builtin_shufflevector(__builtin_bit_cast(i32x4, x), __builtin_bit_cast(i32x4, y), 0, 1, 2, 3, 4, 5, 6, 7)
#define PG8_MMA(ai, bj, At, Bt) do { __builtin_amdgcn_s_setprio(1); \
        if constexpr (FP8) { _Pragma("unroll") for (int m = 0; m < 4; ++m) _Pragma("unroll") for (int n = 0; n < 2; ++n) \
            { const i32x8 b8_ = PG8_CAT8(Bt[n][0], Bt[n][1]), a8_ = PG8_CAT8(At[m][0], At[m][1]); asm volatile("v_mfma_f32_16x16x128_f8f6f4 %0, %1, %2, %0" : "+v"(acc[ai][bj][m][n]) : "v"(b8_), "v"(a8_)); } } \
        else { _Pragma("unroll") for (int m = 0; m < 4; ++m) _Pragma("unroll") for (int n = 0; n < 2; ++n) _Pragma("unroll") for (int k = 0; k < 2; ++k) \
            acc[ai][bj][m][n] = __builtin_amdgcn_mfma_f32_16x16x32_bf16(Bt[n][k], At[m][k], acc[ai][bj][m][n], 0, 0, 0); } \
        __builtin_amdgcn_s_setprio(0); } while (0)
#define PG8_WAIT_V(n) asm volatile("s_waitcnt vmcnt(" #n ")" ::: "memory")
#define PG8_WAIT_L(n) asm volatile("s_waitcnt lgkmcnt(" #n ")" ::: "memory")
#define PG8_BAR __builtin_amdgcn_s_barrier()
#define PG8_SCHED __builtin_amdgcn_sched_barrier(0)
    Unit cur, nxt; int ui = 0;
    if (!S.next(0, cur)) return;
    f32x4 acc[2][2][4][2];
#pragma unroll
    for (int a = 0; a < 2; ++a)
#pragma unroll
        for (int b = 0; b < 2; ++b)
#pragma unroll
            for (int m = 0; m < 4; ++m)
#pragma unroll
                for (int n = 0; n < 2; ++n) acc[a][b][m][n] = (f32x4){0.f, 0.f, 0.f, 0.f};
    bf16x8 At[4][2], B0[2][2], B1[2][2];
    const char* cA = (const char*)g.A + (size_t)cur.pm * tstep + (size_t)cur.k0 * (TILED ? KEB : 2); const char* cB = (const char*)g.Bt + (size_t)cur.pn * tstep + (size_t)cur.k0 * (TILED ? KEB : 2);
    int ntc = (cur.nt & 255) ? (cur.nt & 255) : nt;
    S.a_ready(cur);
    if constexpr (SP2) {
        PG8_STAGE(PG8_SB(0, 0), cB, voffB); PG8_STAGE(PG8_SB(0, 1), cB + hstep, voffB); PG8_STAGE(PG8_SA(0, 0), cA, voffA); PG8_STAGE(PG8_SA(0, 1), cA + hstep, voffA);
        if (wr == 1) PG8_BAR;
        PG8_WAIT_V(2); PG8_BAR;
        PG8_STAGE(PG8_SB(1, 0), cB + kstep, voffB); PG8_STAGE(PG8_SA(1, 0), cA + kstep, voffA); PG8_STAGE(PG8_SB(1, 1), cB + hstep + kstep, voffB);
        PG8_WAIT_V(6); PG8_BAR;
    } else {
        PG8_STAGE(PG8_SB(0, 0), cB, voffB); PG8_STAGE(PG8_SA(0, 0), cA, voffA); PG8_STAGE(PG8_SB(0, 1), cB + hstep, voffB); PG8_STAGE(PG8_SA(0, 1), cA + hstep, voffA);
        if (wr == 1) PG8_BAR;
        PG8_WAIT_V(4); PG8_BAR;
        PG8_STAGE(PG8_SB(1, 0), cB + kstep, voffB); PG8_STAGE(PG8_SA(1, 0), cA + kstep, voffA); PG8_STAGE(PG8_SB(1, 1), cB + hstep + kstep, voffB);
        PG8_WAIT_V(6); PG8_BAR;
    }
    for (;;) {
        const bool has_next = S.next(ui + 1, nxt);
        const char* nA = has_next ? (const char*)g.A + (size_t)nxt.pm * tstep + (size_t)nxt.k0 * (TILED ? KEB : 2) : cA; const char* nB = has_next ? (const char*)g.Bt + (size_t)nxt.pn * tstep + (size_t)nxt.k0 * (TILED ? KEB : 2) : cB;
        for (int t = 0; t < ntc; t += 2) {
            const bool last = (t == ntc - 2);
            const char* a1 = cA + (size_t)(t + 1) * kstep;
            const char* a2 = last ? nA : cA + (size_t)(t + 2) * kstep; const char* b2 = last ? nB : cB + (size_t)(t + 2) * kstep;
            const char* a3 = a2 + kstep; const char* b3 = b2 + kstep;
            if (last && has_next) S.a_ready(nxt);
            if constexpr (SP2) {
            PG8_LDB(B0, 0, 0); PG8_LDB(B1, 0, 1); PG8_SCHED; PG8_LDA(At, 0, 0); PG8_STAGE(PG8_SA(1, 1), a1 + hstep, voffA);
            PG8_WAIT_V(8); PG8_WAIT_L(0); PG8_BAR; PG8_MMA(0, 0, At, B0); PG8_MMA(0, 1, At, B1); PG8_BAR; PG8_SCHED;
            PG8_LDA(At, 0, 1); PG8_STAGE(PG8_SB(0, 0), b2, voffB); PG8_STAGE(PG8_SB(0, 1), b2 + hstep, voffB); PG8_STAGE(PG8_SA(0, 0), a2, voffA);
            PG8_WAIT_V(8); PG8_WAIT_L(0); PG8_BAR; PG8_MMA(1, 0, At, B0); PG8_MMA(1, 1, At, B1); PG8_BAR; PG8_SCHED;
            PG8_LDB(B0, 1, 0); PG8_LDB(B1, 1, 1); PG8_SCHED; PG8_LDA(At, 1, 0); PG8_STAGE(PG8_SA(0, 1), a2 + hstep, voffA);
            PG8_WAIT_V(8); PG8_WAIT_L(0); PG8_BAR; PG8_MMA(0, 0, At, B0); PG8_MMA(0, 1, At, B1); PG8_BAR; PG8_SCHED;
            PG8_LDA(At, 1, 1); PG8_STAGE(PG8_SB(1, 0), b3, voffB); PG8_STAGE(PG8_SB(1, 1), b3 + hstep, voffB); PG8_STAGE(PG8_SA(1, 0), a3, voffA);
            PG8_WAIT_V(8); PG8_WAIT_L(0); PG8_BAR; PG8_MMA(1, 0, At, B0); PG8_MMA(1, 1, At, B1); PG8_BAR; PG8_SCHED;
            } else {
            PG8_LDB(B0, 0, 0); PG8_SCHED; PG8_LDA(At, 0, 0); PG8_STAGE(PG8_SA(1, 1), a1 + hstep, voffA);
            PG8_WAIT_L(8); PG8_BAR; PG8_WAIT_L(0); PG8_MMA(0, 0, At, B0); PG8_BAR; PG8_SCHED;
            PG8_LDB(B1, 0, 1); PG8_STAGE(PG8_SB(0, 0), b2, voffB);
            PG8_BAR; PG8_WAIT_L(0); PG8_MMA(0, 1, At, B1); PG8_BAR;
            PG8_LDA(At, 0, 1); PG8_STAGE(PG8_SA(0, 0), a2, voffA);
            PG8_BAR; PG8_WAIT_L(0); PG8_MMA(1, 0, At, B0); PG8_BAR; PG8_SCHED;
            PG8_STAGE(PG8_SB(0, 1), b2 + hstep, voffB);
            PG8_WAIT_V(6); PG8_BAR; PG8_MMA(1, 1, At, B1); PG8_BAR;
            PG8_LDB(B0, 1, 0); PG8_SCHED; PG8_LDA(At, 1, 0); PG8_STAGE(PG8_SA(0, 1), a2 + hstep, voffA);
            PG8_WAIT_L(8); PG8_BAR; PG8_WAIT_L(0); PG8_MMA(0, 0, At, B0); PG8_BAR; PG8_SCHED;
            PG8_LDB(B1, 1, 1); PG8_STAGE(PG8_SB(1, 0), b3, voffB);
            PG8_BAR; PG8_WAIT_L(0); PG8_MMA(0, 1, At, B1); PG8_BAR;
            PG8_LDA(At, 1, 1); PG8_STAGE(PG8_SA(1, 0), a3, voffA);
            PG8_BAR; PG8_WAIT_L(0); PG8_MMA(1, 0, At, B0); PG8_BAR; PG8_SCHED;
            PG8_STAGE(PG8_SB(1, 1), b3 + hstep, voffB);
            PG8_WAIT_V(6); PG8_BAR; PG8_MMA(1, 1, At, B1); PG8_BAR;
            }
        }
        if constexpr (FP8) asm volatile("s_nop 15\n\ts_nop 15" ::: "memory");
        if constexpr (ALIGN_EPI) { if (wr == 0) PG8_BAR; }
        if constexpr (!Epi::AFTER_DRAIN) { E(acc, cur, wr, wc, fr, fq); S.done(cur); }
        if (!has_next) break;
#pragma unroll
        for (int a = 0; a < 2; ++a)
#pragma unroll
            for (int b = 0; b < 2; ++b)
#pragma unroll
                for (int m = 0; m < 4; ++m)
#pragma unroll
                    for (int n = 0; n < 2; ++n) acc[a][b][m][n] = (f32x4){0.f, 0.f, 0.f, 0.f};
        cur = nxt; cA = nA; cB = nB; ++ui; ntc = (cur.nt & 255) ? (cur.nt & 255) : nt;
        if constexpr (ALIGN_EPI) { if (wr == 1) PG8_BAR; }
    }
    PG8_WAIT_V(0);
    if constexpr (!ALIGN_EPI) { if (wr == 0) PG8_BAR; }
    PG8_BAR;
    if constexpr (Epi::AFTER_DRAIN) { E.fused(acc, cur, wr, wc, fr, fq, lds, wid, lane); S.done(cur); }
#undef PG8_SA
#undef PG8_SB
#undef PG8_STAGE
#undef PG8_LDA
#undef PG8_LDB
#undef PG8_MMA
#undef PG8_CAT8
#undef PG8_WAIT_V
#undef PG8_WAIT_L
#undef PG8_BAR
#undef PG8_SCHED
}
}
constexpr int D_MODEL = 2048, SEQ = 16384, N_META = 16, L_TOK = SEQ + N_META, MPAD = 16640;
constexpr int A_HEADS = 8, A_QRANK = 512, A_KVRANK = 256, A_NOPE = 128, A_ROPE = 64, A_V = 128, A_IN = 832;
constexpr int B_HEADS = 8, B_KVH = 2, B_HD = 128;
constexpr int EVEN_IN = 2368, ZLD = 2560;
constexpr int C_HEADS = 32, C_KVH = 4, C_HD = 64, C_QKV = 2560;
constexpr int D_FF = 7168, N_EXP = 8;
constexpr int MOE_ROWS = 136 * 256;
constexpr float RMS_EPS = 1e-6f;
constexpr float SC_X = 32.f, SC_WGU = 1024.f, SC_ACT = 8.f, SC_WDN = 2048.f, SC_Y = 32.f;
__host__ __device__ __forceinline__ int kvrow(int r) { return r < SEQ ? r + 64 : (r < SEQ + 64 ? r - SEQ : r); }
constexpr int QA_LD = A_HEADS * 192, VA_LD = A_HEADS * 128, QB_LD = B_HEADS * 128, KB_LD = B_KVH * 128;

typedef unsigned short bf16_t;
typedef float f32x4 __attribute__((ext_vector_type(4)));
typedef unsigned u32x4 __attribute__((ext_vector_type(4)));
typedef unsigned u32x2 __attribute__((ext_vector_type(2)));

__device__ __forceinline__ float bf2f(unsigned short b) { return __builtin_bit_cast(float, (unsigned)b << 16); }
__device__ __forceinline__ float bflo(unsigned w) { return __builtin_bit_cast(float, w << 16); }
__device__ __forceinline__ float bfhi(unsigned w) { return __builtin_bit_cast(float, w & 0xffff0000u); }
__device__ __forceinline__ unsigned pkbf(float lo, float hi) { return pg8::cvt_pk_bf16(lo, hi); }
__device__ __forceinline__ float silu_f(float x) { return x * __builtin_amdgcn_rcpf(1.0f + __builtin_amdgcn_exp2f(-1.4426950408889634f * x)); }

struct EpiF32 {
    static constexpr bool PERM = false, AFTER_DRAIN = false;
    float* C; int ldc; const float* bias; float* Cpart; int kchunk;
    __device__ __forceinline__ void operator()(const pg8::f32x4 (&acc)[2][2][4][2], const pg8::Unit& u, int wr, int wc, int fr, int fq) const {
        if (u.nt != 0) { float* P = Cpart + (size_t)(u.k0 / kchunk) * 256 * ldc; const int r0 = wr * 64 + fr, c0 = u.pn * 256 + wc * 32 + 4 * fq;
#pragma unroll
            for (int ai = 0; ai < 2; ++ai)
#pragma unroll
                for (int m = 0; m < 4; ++m)
#pragma unroll
                    for (int bj = 0; bj < 2; ++bj)
#pragma unroll
                        for (int n = 0; n < 2; ++n) *(f32x4*)(P + (size_t)(r0 + ai * 128 + m * 16) * ldc + c0 + bj * 128 + n * 16) = acc[ai][bj][m][n];
            return; }
        const int row0 = u.pm * 256 + wr * 64 + fr, col0 = u.pn * 256 + wc * 32 + 4 * fq;
        f32x4 bv[2][2];
#pragma unroll
        for (int bj = 0; bj < 2; ++bj)
#pragma unroll
            for (int n = 0; n < 2; ++n) bv[bj][n] = bias ? *(const f32x4*)(bias + col0 + bj * 128 + n * 16) : (f32x4){0.f, 0.f, 0.f, 0.f};
#pragma unroll
        for (int ai = 0; ai < 2; ++ai)
#pragma unroll
            for (int m = 0; m < 4; ++m) { float* rowp = C + (size_t)(row0 + ai * 128 + m * 16) * ldc + col0;
#pragma unroll
                for (int bj = 0; bj < 2; ++bj)
#pragma unroll
                    for (int n = 0; n < 2; ++n) *(f32x4*)(rowp + bj * 128 + n * 16) = acc[ai][bj][m][n] + bv[bj][n]; }
    }
};
struct EpiYBf16 {
    static constexpr bool PERM = true, AFTER_DRAIN = false;
    bf16_t* Yb; int ldc; const float* bias; float* Cpart; int kchunk;
    __device__ __forceinline__ void operator()(const pg8::f32x4 (&acc)[2][2][4][2], const pg8::Unit& u, int wr, int wc, int fr, int fq) const {
        const int r0 = wr * 64 + fr, c0 = u.pn * 256 + wc * 32 + 8 * fq;
        if (u.nt != 0) { float* P = Cpart + (size_t)(u.k0 / kchunk) * 256 * ldc;
#pragma unroll
            for (int ai = 0; ai < 2; ++ai)
#pragma unroll
                for (int m = 0; m < 4; ++m)
#pragma unroll
                    for (int bj = 0; bj < 2; ++bj) { float* p = P + (size_t)(r0 + ai * 128 + m * 16) * ldc + c0 + bj * 128; *(f32x4*)p = acc[ai][bj][m][0]; *(f32x4*)(p + 4) = acc[ai][bj][m][1]; }
            return; }
        f32x4 bv[2][2];
#pragma unroll
        for (int bj = 0; bj < 2; ++bj)
#pragma unroll
            for (int n = 0; n < 2; ++n) bv[bj][n] = bias ? *(const f32x4*)(bias + c0 + bj * 128 + 4 * n) : (f32x4){0.f, 0.f, 0.f, 0.f};
#pragma unroll
        for (int ai = 0; ai < 2; ++ai)
#pragma unroll
            for (int m = 0; m < 4; ++m) { bf16_t* rowp = Yb + (size_t)(u.pm * 256 + r0 + ai * 128 + m * 16) * ldc + c0;
#pragma unroll
                for (int bj = 0; bj < 2; ++bj) { const f32x4 v0 = acc[ai][bj][m][0] + bv[bj][0], v1 = acc[ai][bj][m][1] + bv[bj][1];
                    u32x4 w; w.x = pkbf(v0[0], v0[1]); w.y = pkbf(v0[2], v0[3]); w.z = pkbf(v1[0], v1[1]); w.w = pkbf(v1[2], v1[3]);
                    *(u32x4*)(rowp + bj * 128) = w; } }
    }
};
struct EpiStoreBf16 {
    static constexpr bool PERM = true, AFTER_DRAIN = false;
    bf16_t* O; int ldc; int pn_mod; bf16_t* O2;
    __device__ __forceinline__ void operator()(const pg8::f32x4 (&acc)[2][2][4][2], const pg8::Unit& u, int wr, int wc, int fr, int fq) const {
        const int row0 = u.pm * 256 + wr * 64 + fr, col0 = (u.pn % pn_mod) * 256 + wc * 32 + 8 * fq; bf16_t* const Ob = u.k0 ? O2 : O;
#pragma unroll
        for (int ai = 0; ai < 2; ++ai)
#pragma unroll
            for (int m = 0; m < 4; ++m) { bf16_t* rowp = Ob + (size_t)(row0 + ai * 128 + m * 16) * ldc + col0;
#pragma unroll
                for (int bj = 0; bj < 2; ++bj) { const f32x4 v0 = acc[ai][bj][m][0], v1 = acc[ai][bj][m][1];
                    u32x4 w; w.x = pkbf(v0[0], v0[1]); w.y = pkbf(v0[2], v0[3]); w.z = pkbf(v1[0], v1[1]); w.w = pkbf(v1[2], v1[3]);
                    *(u32x4*)(rowp + bj * 128) = w; } }
    }
};
struct EpiSwiGLU {
    static constexpr bool PERM = true, AFTER_DRAIN = false;
    bf16_t* O; int ldc; int pn_mod; int tiled;
    float* SP;
    __device__ __forceinline__ void operator()(const pg8::f32x4 (&acc)[2][2][4][2], const pg8::Unit& u, int wr, int wc, int fr, int fq) const {
        if (u.nt != 0) {
            if (wr == 0) { float* p = SP + ((size_t)((u.k0 >> 9) * pn_mod + u.pn) * 16 + fr) * 256 + wc * 32 + 8 * fq;
#pragma unroll
                for (int bj = 0; bj < 2; ++bj) { *(f32x4*)(p + bj * 128) = acc[0][bj][0][0]; *(f32x4*)(p + bj * 128 + 4) = acc[0][bj][0][1]; } }
            return; }
        const int row0 = u.pm * 256 + wr * 64 + fr, col0 = (u.pn % pn_mod) * 128 + wc * 32 + 8 * fq;
#pragma unroll
        for (int ai = 0; ai < 2; ++ai)
#pragma unroll
            for (int m = 0; m < 4; ++m) {
                const f32x4 g0 = acc[ai][0][m][0], g1 = acc[ai][0][m][1], u0 = acc[ai][1][m][0], u1 = acc[ai][1][m][1];
                u32x4 w;
                w.x = pkbf(silu_f(g0[0]) * u0[0], silu_f(g0[1]) * u0[1]); w.y = pkbf(silu_f(g0[2]) * u0[2], silu_f(g0[3]) * u0[3]);
                w.z = pkbf(silu_f(g1[0]) * u1[0], silu_f(g1[1]) * u1[1]); w.w = pkbf(silu_f(g1[2]) * u1[2], silu_f(g1[3]) * u1[3]);
                const int row = row0 + ai * 128 + m * 16;
                bf16_t* p = tiled ? O + ((size_t)(row >> 8) * (ldc >> 6) + (col0 >> 6)) * 16384 + (row & 255) * 64 + (col0 & 63) : O + (size_t)row * ldc + col0;
                *(u32x4*)p = w; }
    }
};
__device__ __forceinline__ unsigned pkf8x4(float a, float b, float c, float d) {
    a = __builtin_amdgcn_fmed3f(a, -448.f, 448.f); b = __builtin_amdgcn_fmed3f(b, -448.f, 448.f); c = __builtin_amdgcn_fmed3f(c, -448.f, 448.f); d = __builtin_amdgcn_fmed3f(d, -448.f, 448.f);
    int w = __builtin_amdgcn_cvt_pk_fp8_f32(a, b, 0, false); w = __builtin_amdgcn_cvt_pk_fp8_f32(c, d, w, true); return (unsigned)w; }
struct EpiSwiGLU8 {
    static constexpr bool PERM = true, AFTER_DRAIN = false;
    unsigned char* O; int ldc; int pn_mod; float sin, sout;
    __device__ __forceinline__ void operator()(const pg8::f32x4 (&acc)[2][2][4][2], const pg8::Unit& u, int wr, int wc, int fr, int fq) const {
        const int row0 = u.pm * 256 + wr * 64 + fr, ct = u.pn % pn_mod, cb = wc * 32 + 8 * fq;
        const float c1 = -1.4426950408889634f * sin, ic2 = 1.0f / (sin * sin * sout);
#pragma unroll
        for (int ai = 0; ai < 2; ++ai)
#pragma unroll
            for (int m = 0; m < 4; ++m) {
                const f32x4 g0 = acc[ai][0][m][0], g1 = acc[ai][0][m][1], u0 = acc[ai][1][m][0], u1 = acc[ai][1][m][1];
#define SWG8(G, U) (((G) * (U)) * __builtin_amdgcn_rcpf(fmaf(__builtin_amdgcn_exp2f((G) * c1), ic2, ic2)))
                u32x2 w;
                w.x = pkf8x4(SWG8(g0[0], u0[0]), SWG8(g0[1], u0[1]), SWG8(g0[2], u0[2]), SWG8(g0[3], u0[3]));
                w.y = pkf8x4(SWG8(g1[0], u1[0]), SWG8(g1[1], u1[1]), SWG8(g1[2], u1[2]), SWG8(g1[3], u1[3]));
#undef SWG8
                const int row = row0 + ai * 128 + m * 16;
                *(u32x2*)(O + ((size_t)(row >> 8) * (ldc >> 7) + ct) * 32768 + (row & 255) * 128 + cb) = w; }
    }
};
__device__ __forceinline__ void rope4(f32x4& v0, f32x4& v1, const f32x4 c, const f32x4 s) {
    float a, b;
    a = v0[0]; b = v0[1]; v0[0] = a * c[0] - b * s[0]; v0[1] = b * c[0] + a * s[0];
    a = v0[2]; b = v0[3]; v0[2] = a * c[1] - b * s[1]; v0[3] = b * c[1] + a * s[1];
    a = v1[0]; b = v1[1]; v1[0] = a * c[2] - b * s[2]; v1[1] = b * c[2] + a * s[2];
    a = v1[2]; b = v1[3]; v1[2] = a * c[3] - b * s[3]; v1[3] = b * c[3] + a * s[3];
}
struct EpiQA {
    static constexpr bool PERM = true, AFTER_DRAIN = false;
    bf16_t* QA; const float* AC; const float* AS;
    __device__ __forceinline__ void operator()(const pg8::f32x4 (&acc)[2][2][4][2], const pg8::Unit& u, int wr, int wc, int fr, int fq) const {
        const int row0 = u.pm * 256 + wr * 64 + fr;
#pragma unroll
        for (int bj = 0; bj < 2; ++bj) {
            const int c0 = u.pn * 256 + bj * 128 + wc * 32 + 8 * fq, d = c0 % 192; const bool rot = d >= 128; const int i0 = rot ? ((d - 128) >> 1) : 0;
#pragma unroll
            for (int ai = 0; ai < 2; ++ai)
#pragma unroll
                for (int m = 0; m < 4; ++m) { const int row = row0 + ai * 128 + m * 16;
                    f32x4 v0 = acc[ai][bj][m][0], v1 = acc[ai][bj][m][1];
                    if (rot) { const f32x4 c = *(const f32x4*)(AC + (size_t)row * 32 + i0), s = *(const f32x4*)(AS + (size_t)row * 32 + i0); rope4(v0, v1, c, s); }
                    u32x4 w; w.x = pkbf(v0[0], v0[1]); w.y = pkbf(v0[2], v0[3]); w.z = pkbf(v1[0], v1[1]); w.w = pkbf(v1[2], v1[3]);
                    *(u32x4*)(QA + (size_t)row * QA_LD + c0) = w; }
        }
    }
};
struct EpiKV {
    static constexpr bool PERM = true, AFTER_DRAIN = false;
    bf16_t* KA; bf16_t* VA;
    __device__ __forceinline__ void operator()(const pg8::f32x4 (&acc)[2][2][4][2], const pg8::Unit& u, int wr, int wc, int fr, int fq) const {
        const int row0 = u.pm * 256 + wr * 64 + fr, h = u.pn, d0 = wc * 32 + 8 * fq;
#pragma unroll
        for (int ai = 0; ai < 2; ++ai)
#pragma unroll
            for (int m = 0; m < 4; ++m) { const int row = row0 + ai * 128 + m * 16;
#pragma unroll
                for (int bj = 0; bj < 2; ++bj) { const f32x4 v0 = acc[ai][bj][m][0], v1 = acc[ai][bj][m][1];
                    u32x4 w; w.x = pkbf(v0[0], v0[1]); w.y = pkbf(v0[2], v0[3]); w.z = pkbf(v1[0], v1[1]); w.w = pkbf(v1[2], v1[3]);
                    const int kr = kvrow(row);
                    bf16_t* p = (bj == 0) ? (KA + (size_t)kr * QA_LD + h * 192 + d0) : (VA + (size_t)kr * VA_LD + h * 128 + d0);
                    *(u32x4*)p = w; } }
    }
};
struct EpiQKV {
    static constexpr bool PERM = true, AFTER_DRAIN = false;
    bf16_t* O; const float* biasp; const float* CC; const float* CS;
    __device__ __forceinline__ void operator()(const pg8::f32x4 (&acc)[2][2][4][2], const pg8::Unit& u, int wr, int wc, int fr, int fq) const {
        const int row0 = u.pm * 256 + wr * 64 + fr;
#pragma unroll
        for (int bj = 0; bj < 2; ++bj) {
            const int c0 = u.pn * 256 + bj * 128 + wc * 32 + 8 * fq, d = c0 & 63; const bool rot = (c0 < 2304) && (d < 16); const int i0 = rot ? (d >> 1) : 0;
            const f32x4 b0 = *(const f32x4*)(biasp + c0), b1 = *(const f32x4*)(biasp + c0 + 4);
#pragma unroll
            for (int ai = 0; ai < 2; ++ai)
#pragma unroll
                for (int m = 0; m < 4; ++m) { const int row = row0 + ai * 128 + m * 16;
                    f32x4 v0 = acc[ai][bj][m][0] + b0, v1 = acc[ai][bj][m][1] + b1;
                    if (rot) { const f32x4 c = *(const f32x4*)(CC + (size_t)row * 8 + i0), s = *(const f32x4*)(CS + (size_t)row * 8 + i0); rope4(v0, v1, c, s); }
                    u32x4 w; w.x = pkbf(v0[0], v0[1]); w.y = pkbf(v0[2], v0[3]); w.z = pkbf(v1[0], v1[1]); w.w = pkbf(v1[2], v1[3]);
                    *(u32x4*)(O + (size_t)row * C_QKV + c0) = w; }
        }
    }
};
struct MoeOrder {
    pg8::StaticOrder S; const int* blk_e; int nN;
    __device__ void init(int nblk, int nN_, int G, int c, const int* be, int wgm_ = 8) { S.init(nblk * 256, nN_ * 256, G, c, wgm_); blk_e = be; nN = nN_; }
    __device__ bool next(int i, pg8::Unit& u) const { if (!S.next(i, u)) return false; const int e = __builtin_amdgcn_readfirstlane(blk_e[u.pm]); u.pn += e * nN; return true; }
    __device__ __forceinline__ void a_ready(const pg8::Unit&) const {}
    __device__ __forceinline__ void done(const pg8::Unit&) const {}
};
struct MoeSplit2Order {
    pg8::StaticOrder S; const int* blk_e; int nN, khalf;
    __device__ void init(int nblk, int nN_, int K, int G, int c, const int* be) { S.init(nblk * 256, 2 * nN_ * 256, G, c); blk_e = be; nN = nN_; khalf = K / 2; }
    __device__ bool next(int i, pg8::Unit& u) const { if (!S.next(i, u)) return false; const int e = __builtin_amdgcn_readfirstlane(blk_e[u.pm]); const int ks = u.pn / nN;
        u.pn = (u.pn - ks * nN) + e * nN; u.k0 = ks * khalf; u.nt = khalf / 64; return true; }
    __device__ __forceinline__ void a_ready(const pg8::Unit&) const {}
    __device__ __forceinline__ void done(const pg8::Unit&) const {}
};
struct MoeTailOrder {
    pg8::StaticOrder S; const int* blk_e; int nN, K, RG, Lf, s, G, c;
    __device__ __forceinline__ static int pick_s(int Lf, int G) { return Lf == 0 ? 1 : (Lf * 4 <= G ? 4 : (Lf * 2 <= G ? 2 : 1)); }
    __device__ __forceinline__ void init(int nblk, int nN_, int K_, int G_, int c_, const int* be) { S.init(nblk * 256, nN_ * 256, G_, c_); blk_e = be; nN = nN_; K = K_; G = G_; c = c_;
        const int U = nblk * nN_; RG = (U / G_) * G_; Lf = U - RG; s = pick_s(Lf, G_); }
    __device__ __forceinline__ bool next(int i, pg8::Unit& u) const {
        const long L = (long)i * G + c;
        if (L < RG) S.map((int)L, u);
        else { const int e = (int)(L - RG); if (e >= Lf * s) return false; const int j = e % Lf, ks = e / Lf; S.map(RG + j, u);
            if (s > 1) { u.k0 = ks * (K / s); u.nt = (K / s / 128) | ((j * s + ks) << 8); } }
        const int ex = __builtin_amdgcn_readfirstlane(blk_e[u.pm]); u.pn += ex * nN; return true;
    }
    __device__ __forceinline__ void a_ready(const pg8::Unit&) const {}
    __device__ __forceinline__ void done(const pg8::Unit&) const {}
};
struct EpiMoeDown {
    static constexpr bool PERM = true, AFTER_DRAIN = false;
    bf16_t* O; int ldc; int pn_mod; float* SP; float sc;
    __device__ __forceinline__ void operator()(const pg8::f32x4 (&acc)[2][2][4][2], const pg8::Unit& u, int wr, int wc, int fr, int fq) const {
        const int r0 = wr * 64 + fr, c0 = wc * 32 + 8 * fq;
        if (u.nt != 0) { float* P = SP + (size_t)(u.nt >> 8) * 65536;
#pragma unroll
            for (int ai = 0; ai < 2; ++ai)
#pragma unroll
                for (int m = 0; m < 4; ++m)
#pragma unroll
                    for (int bj = 0; bj < 2; ++bj) { float* p = P + (r0 + ai * 128 + m * 16) * 256 + c0 + bj * 128; *(f32x4*)p = acc[ai][bj][m][0] * sc; *(f32x4*)(p + 4) = acc[ai][bj][m][1] * sc; }
            return; }
#pragma unroll
        for (int ai = 0; ai < 2; ++ai)
#pragma unroll
            for (int m = 0; m < 4; ++m) { unsigned char* rowp = (unsigned char*)O + (size_t)(u.pm * 256 + r0 + ai * 128 + m * 16) * ldc + (u.pn % pn_mod) * 256 + c0;
#pragma unroll
                for (int bj = 0; bj < 2; ++bj) { const f32x4 v0 = acc[ai][bj][m][0] * (sc * SC_Y), v1 = acc[ai][bj][m][1] * (sc * SC_Y);
                    u32x2 w; w.x = pkf8x4(v0[0], v0[1], v0[2], v0[3]); w.y = pkf8x4(v1[0], v1[1], v1[2], v1[3]);
                    *(u32x2*)(rowp + bj * 128) = w; } }
    }
};
struct MetaSplitOrder {
    pg8::StaticOrder S; int nmain, nN, G, c, kchunk, nsplit;
    __device__ void init(int nN_, int K, int nsplit_, int G_, int c_, int wgm_ = 8) { S.init(64 * 256, nN_ * 256, G_, c_, wgm_); nmain = 64 * nN_; nN = nN_; G = G_; c = c_; nsplit = nsplit_; kchunk = K / nsplit_; }
    __device__ bool next(int i, pg8::Unit& u) const {
        const long L = (long)i * G + c;
        if (L < nmain) return S.next(i, u);
        const int e = (int)(L - nmain); if (e >= nN * nsplit) return false;
        u.pm = 64; u.pn = e % nN; u.k0 = (e / nN) * kchunk; u.nt = kchunk / 64; return true;
    }
    __device__ __forceinline__ void a_ready(const pg8::Unit&) const {}
    __device__ __forceinline__ void done(const pg8::Unit&) const {}
};
struct ProbeOrder {
    MetaSplitOrder S; int zpm, zpn;
    __device__ bool next(int i, pg8::Unit& u) const { if (!S.next(i, u)) return false; if (u.nt == 0) { if (zpm) u.pm = 0; if (zpn) u.pn = 0; } return true; }
    __device__ __forceinline__ void a_ready(const pg8::Unit&) const {}
    __device__ __forceinline__ void done(const pg8::Unit&) const {}
};
struct RowsPlusOrder {
    pg8::StaticOrder S; int nmain, pn_lo, nN, nMr, G, c;
    __device__ void init(int nMr_, int nN_, int pn_lo_, int G_, int c_) { S.init(nMr_ * 256, nN_ * 256, G_, c_); nmain = nMr_ * nN_; pn_lo = pn_lo_; nN = nN_; nMr = nMr_; G = G_; c = c_; }
    __device__ bool next(int i, pg8::Unit& u) const {
        const long L = (long)i * G + c;
        if (L < nmain) return S.next(i, u);
        const int e = (int)(L - nmain); if (e >= nN - pn_lo) return false;
        u.pm = nMr; u.pn = pn_lo + e; u.k0 = 0; u.nt = 0; return true;
    }
    __device__ __forceinline__ void a_ready(const pg8::Unit&) const {}
    __device__ __forceinline__ void done(const pg8::Unit&) const {}
};
namespace att {
#define LAS3 __attribute__((address_space(3)))
using bf16x8 = __attribute__((ext_vector_type(8))) short;
using s16x4  = __attribute__((ext_vector_type(4))) short;
using f32x16 = __attribute__((ext_vector_type(16))) float;
constexpr int NW = 8, QBLK = 32, KVBLK = 64;
constexpr int SHM_V = KVBLK * 128 * 2;
constexpr float LOG2E = 1.4426950408889634f;
#define SBAR() __builtin_amdgcn_sched_barrier(0)
#ifndef QK_SB_MASK
#define QK_SB_MASK 0x1F
#endif
__device__ __forceinline__ int crow(int r, int hi) { return (r & 3) + 8 * (r >> 2) + 4 * hi; }
typedef float f32x2_t __attribute__((ext_vector_type(2))); typedef __bf16 bf16x2_t __attribute__((ext_vector_type(2)));
__device__ __forceinline__ unsigned cvtpk(float lo, float hi) { f32x2_t v = {lo, hi}; bf16x2_t b = __builtin_convertvector(v, bf16x2_t); return __builtin_bit_cast(unsigned, b); }
template <int NMFMA, int NVALU> __device__ __forceinline__ void interleave_qk_sm() {
#ifdef QK_PIPE
  __builtin_amdgcn_sched_group_barrier(0x100, 2, 0);
#pragma unroll
  for (int i = 0; i < NMFMA / 2; ++i) { __builtin_amdgcn_sched_group_barrier(0x100, 2, 0);
    __builtin_amdgcn_sched_group_barrier(0x008, 1, 0); __builtin_amdgcn_sched_group_barrier(0x002, NVALU, 0);
    __builtin_amdgcn_sched_group_barrier(0x008, 1, 0); __builtin_amdgcn_sched_group_barrier(0x002, NVALU, 0); }
#else
#pragma unroll
  for (int i = 0; i < NMFMA; ++i) { __builtin_amdgcn_sched_group_barrier(0x008, 1, 0); __builtin_amdgcn_sched_group_barrier(0x100, 1, 0); __builtin_amdgcn_sched_group_barrier(0x002, NVALU, 0); }
#endif
}
constexpr int KDSTR = 2080;
constexpr int KHSTR = 1040;
__device__ __forceinline__ int kimg(int row, int c8) { return (c8 >> 1) * KDSTR + (c8 & 1) * KHSTR + row * 16; }

__device__ __forceinline__ void partialSM(f32x16& p0, f32x16& p1, float& m_reg, float& mn, float& alpha, const float C, const float thr, const int nvalid, const int hi) {
  if (nvalid < KVBLK) {
#pragma unroll
    for (int r = 0; r < 16; ++r) { const int k = crow(r, hi); if (k >= nvalid) p0[r] = -1e30f; if (k + 32 >= nvalid) p1[r] = -1e30f; }
  }
  float pmax = p0[0];
#pragma unroll
  for (int r = 1; r < 16; ++r) pmax = fmaxf(pmax, p0[r]);
#pragma unroll
  for (int r = 0; r < 16; ++r) pmax = fmaxf(pmax, p1[r]);
  { auto rr = __builtin_amdgcn_permlane32_swap(__float_as_uint(pmax), __float_as_uint(pmax), false, false);
    pmax = fmaxf(__uint_as_float(rr[0]), __uint_as_float(rr[1])); }
  if (__builtin_expect(__all(pmax - m_reg <= thr), 1)) { mn = m_reg; alpha = 1.f; }
  else { mn = fmaxf(m_reg, pmax); alpha = __builtin_amdgcn_exp2f((m_reg - mn) * C); m_reg = mn; }
  const float mnC = -mn * C;
#ifdef QSCALE
  p0 = p0 + mnC; p1 = p1 + mnC;
#else
#pragma unroll
  for (int r = 0; r < 16; ++r) p0[r] = fmaf(p0[r], C, mnC);
#pragma unroll
  for (int r = 0; r < 16; ++r) p1[r] = fmaf(p1[r], C, mnC);
#endif
#pragma unroll
  for (int r = 0; r < 16; ++r) p0[r] = __builtin_amdgcn_exp2f(p0[r]);
}
__device__ __forceinline__ void packP(const f32x16& p0, const f32x16& p1, bf16x8& pa0, bf16x8& pa1, bf16x8& pa2, bf16x8& pa3) {
#define PK4(P, BASE, OUT) do { unsigned a0 = cvtpk(P[BASE + 0], P[BASE + 1]), a1 = cvtpk(P[BASE + 2], P[BASE + 3]);   \
    unsigned b0 = cvtpk(P[BASE + 4], P[BASE + 5]), b1 = cvtpk(P[BASE + 6], P[BASE + 7]);                              \
    auto r0 = __builtin_amdgcn_permlane32_swap(a0, b0, false, false); auto r1 = __builtin_amdgcn_permlane32_swap(a1, b1, false, false); \
    u32x4 w = {r0[0], r1[0], r0[1], r1[1]}; OUT = __builtin_bit_cast(bf16x8, w); } while (0)
  PK4(p0, 0, pa0); PK4(p0, 8, pa1); PK4(p1, 0, pa2); PK4(p1, 8, pa3);
#undef PK4
}
__device__ __forceinline__ void finishSM(f32x16& p0, f32x16& p1, float alpha, float& l_reg, bf16x8& pa0, bf16x8& pa1, bf16x8& pa2, bf16x8& pa3) {
#pragma unroll
  for (int r = 0; r < 16; ++r) p1[r] = __builtin_amdgcn_exp2f(p1[r]);
#ifdef QSCALE
  float ps;
  { const f32x16 t = p0 + p1;
    typedef float f32x8_t __attribute__((ext_vector_type(8))); typedef float f32x4_t __attribute__((ext_vector_type(4)));
    const f32x8_t a = __builtin_shufflevector(t, t, 0, 1, 2, 3, 4, 5, 6, 7) + __builtin_shufflevector(t, t, 8, 9, 10, 11, 12, 13, 14, 15);
    const f32x4_t b = __builtin_shufflevector(a, a, 0, 1, 2, 3) + __builtin_shufflevector(a, a, 4, 5, 6, 7);
    const f32x2_t c2 = __builtin_shufflevector(b, b, 0, 1) + __builtin_shufflevector(b, b, 2, 3);
    ps = c2.x + c2.y; }
#else
  float ps = 0;
#pragma unroll
  for (int r = 0; r < 16; ++r) ps += p0[r];
#pragma unroll
  for (int r = 0; r < 16; ++r) ps += p1[r];
#endif
  { auto rr = __builtin_amdgcn_permlane32_swap(__float_as_uint(ps), __float_as_uint(ps), false, false);
    ps = __uint_as_float(rr[0]) + __uint_as_float(rr[1]); }
  l_reg = l_reg * alpha + ps;
  packP(p0, p1, pa0, pa1, pa2, pa3);
}
template <int DK, int QREG> __device__ __forceinline__ void qkt(f32x16& p0, f32x16& p1, const LAS3 char* Kl  , const bf16x8* qr, const LAS3 char* qls) {
  p0 = f32x16{}; p1 = f32x16{};
#ifdef QK_PIPE
  bf16x8 b0 = *(const LAS3 bf16x8*)(Kl), b1 = *(const LAS3 bf16x8*)(Kl + 512);
#pragma unroll
  for (int d0 = 0; d0 < DK / 16; ++d0) {
    bf16x8 n0 = b0, n1 = b1;
    if (d0 + 1 < DK / 16) { n0 = *(const LAS3 bf16x8*)(Kl + (d0 + 1) * KDSTR); n1 = *(const LAS3 bf16x8*)(Kl + (d0 + 1) * KDSTR + 512); }
    bf16x8 q;
    if (d0 < QREG) q = qr[d0]; else q = *(const volatile LAS3 bf16x8*)(qls + (d0 - QREG) * 1024);
    p0 = __builtin_amdgcn_mfma_f32_32x32x16_bf16(b0, q, p0, 0, 0, 0);
    p1 = __builtin_amdgcn_mfma_f32_32x32x16_bf16(b1, q, p1, 0, 0, 0);
    b0 = n0; b1 = n1; }
#else
#pragma unroll
  for (int d0 = 0; d0 < DK / 16; ++d0) {
    const bf16x8 b0 = *(const LAS3 bf16x8*)(Kl + d0 * KDSTR);
    const bf16x8 b1 = *(const LAS3 bf16x8*)(Kl + d0 * KDSTR + 512);
    bf16x8 q;
    if (d0 < QREG) q = qr[d0]; else q = *(const volatile LAS3 bf16x8*)(qls + (d0 - QREG) * 1024);
    p0 = __builtin_amdgcn_mfma_f32_32x32x16_bf16(b0, q, p0, 0, 0, 0);
    p1 = __builtin_amdgcn_mfma_f32_32x32x16_bf16(b1, q, p1, 0, 0, 0); }
#endif
}
template <int NCB> __device__ __forceinline__ int v_st(int k, int c) { const int kk = (k & ~0xC) | ((k & 4) << 1) | ((k & 8) >> 1); return ((kk >> 3) * NCB + (c >> 5)) * 512 + ((kk & 7) * 32 + (c & 31)) * 2; }
__device__ __forceinline__ int v_rd_base(int lane) { return ((lane & 3) << 3) | (((lane >> 2) & 3) << 6) | (((lane >> 4) & 1) << 5) | (((lane >> 5) & 1) << 8); }
template <int NCB> constexpr int v_rd_off(int d0, int ks, int half) { return d0 * 512 + (2 * ks + half) * NCB * 512; }
template <int OFF> __device__ __forceinline__ s16x4 tr_read(int vb) {
  s16x4 r; asm volatile("ds_read_b64_tr_b16 %0, %1 offset:%2" : "=&v"(r) : "v"(vb), "i"(OFF) : "memory"); return r;
}
template <int NCB, int D0> __device__ __forceinline__ void pv_one(f32x16& od, int vb, bf16x8 pa0, bf16x8 pa1, bf16x8 pa2, bf16x8 pa3) {
  const s16x4 l0 = tr_read<v_rd_off<NCB>(D0, 0, 0)>(vb), h0 = tr_read<v_rd_off<NCB>(D0, 0, 1)>(vb), l1 = tr_read<v_rd_off<NCB>(D0, 1, 0)>(vb), h1 = tr_read<v_rd_off<NCB>(D0, 1, 1)>(vb);
  const s16x4 l2 = tr_read<v_rd_off<NCB>(D0, 2, 0)>(vb), h2 = tr_read<v_rd_off<NCB>(D0, 2, 1)>(vb), l3 = tr_read<v_rd_off<NCB>(D0, 3, 0)>(vb), h3 = tr_read<v_rd_off<NCB>(D0, 3, 1)>(vb);
  asm volatile("s_waitcnt lgkmcnt(0)" ::: "memory"); SBAR();
#define PKV(L, H) (bf16x8){L[0], L[1], L[2], L[3], H[0], H[1], H[2], H[3]}
  od = __builtin_amdgcn_mfma_f32_32x32x16_bf16(pa0, PKV(l0, h0), od, 0, 0, 0);
  od = __builtin_amdgcn_mfma_f32_32x32x16_bf16(pa1, PKV(l1, h1), od, 0, 0, 0);
  od = __builtin_amdgcn_mfma_f32_32x32x16_bf16(pa2, PKV(l2, h2), od, 0, 0, 0);
  od = __builtin_amdgcn_mfma_f32_32x32x16_bf16(pa3, PKV(l3, h3), od, 0, 0, 0);
#undef PKV
}
template <int NCB, int D0> __device__ __forceinline__ void v_read(int vb, s16x4 (&f)[8]) {
  f[0] = tr_read<v_rd_off<NCB>(D0, 0, 0)>(vb); f[1] = tr_read<v_rd_off<NCB>(D0, 0, 1)>(vb); f[2] = tr_read<v_rd_off<NCB>(D0, 1, 0)>(vb); f[3] = tr_read<v_rd_off<NCB>(D0, 1, 1)>(vb);
  f[4] = tr_read<v_rd_off<NCB>(D0, 2, 0)>(vb); f[5] = tr_read<v_rd_off<NCB>(D0, 2, 1)>(vb); f[6] = tr_read<v_rd_off<NCB>(D0, 3, 0)>(vb); f[7] = tr_read<v_rd_off<NCB>(D0, 3, 1)>(vb);
}
__device__ __forceinline__ void v_mma(f32x16& od, const s16x4 (&f)[8], bf16x8 pa0, bf16x8 pa1, bf16x8 pa2, bf16x8 pa3) {
#define PKV(L, H) (bf16x8){L[0], L[1], L[2], L[3], H[0], H[1], H[2], H[3]}
  od = __builtin_amdgcn_mfma_f32_32x32x16_bf16(pa0, PKV(f[0], f[1]), od, 0, 0, 0);
  od = __builtin_amdgcn_mfma_f32_32x32x16_bf16(pa1, PKV(f[2], f[3]), od, 0, 0, 0);
  od = __builtin_amdgcn_mfma_f32_32x32x16_bf16(pa2, PKV(f[4], f[5]), od, 0, 0, 0);
  od = __builtin_amdgcn_mfma_f32_32x32x16_bf16(pa3, PKV(f[6], f[7]), od, 0, 0, 0);
#undef PKV
}
#define LGKM_WAIT(n) asm volatile("s_waitcnt lgkmcnt(" #n ")" ::: "memory")
__device__ __forceinline__ void pv_sm(f32x16* o, int vb, bf16x8 pa0, bf16x8 pa1, bf16x8 pa2, bf16x8 pa3, f32x16& p0, f32x16& p1, float& m_reg, float& mn, float& alpha, const float C, const float thr) {
#ifdef PV_PIPE
  s16x4 fa[8], fb[8];
  v_read<4, 0>(vb, fa); v_read<4, 1>(vb, fb); LGKM_WAIT(8); SBAR();
  v_mma(o[0], fa, pa0, pa1, pa2, pa3);
#else
  pv_one<4, 0>(o[0], vb, pa0, pa1, pa2, pa3);
#endif
  float pmA = p0[0];
#pragma unroll
  for (int r = 1; r < 16; ++r) pmA = fmaxf(pmA, p0[r]);
#ifdef PV_PIPE
  SBAR(); v_read<4, 2>(vb, fa); LGKM_WAIT(8); SBAR();
  v_mma(o[1], fb, pa0, pa1, pa2, pa3);
#else
  pv_one<4, 1>(o[1], vb, pa0, pa1, pa2, pa3);
#endif
  float pmax = p1[0];
#pragma unroll
  for (int r = 1; r < 16; ++r) pmax = fmaxf(pmax, p1[r]);
  pmax = fmaxf(pmax, pmA);
  { auto rr = __builtin_amdgcn_permlane32_swap(__float_as_uint(pmax), __float_as_uint(pmax), false, false);
    pmax = fmaxf(__uint_as_float(rr[0]), __uint_as_float(rr[1])); }
  const bool keep = __all(pmax - m_reg <= thr);
  mn = keep ? m_reg : fmaxf(m_reg, pmax); alpha = __builtin_amdgcn_exp2f((m_reg - mn) * C); m_reg = mn;
  const float mnC = -mn * C;
#ifdef PV_PIPE
  SBAR(); v_read<4, 3>(vb, fb); LGKM_WAIT(8); SBAR();
  v_mma(o[2], fa, pa0, pa1, pa2, pa3);
#else
  pv_one<4, 2>(o[2], vb, pa0, pa1, pa2, pa3);
#endif
#ifdef QSCALE
  p0 = p0 + mnC; p1 = p1 + mnC;
#else
#pragma unroll
  for (int r = 0; r < 16; ++r) p0[r] = fmaf(p0[r], C, mnC);
#pragma unroll
  for (int r = 0; r < 16; ++r) p1[r] = fmaf(p1[r], C, mnC);
#endif
#ifdef PV_PIPE
  SBAR(); LGKM_WAIT(0); SBAR();
  v_mma(o[3], fb, pa0, pa1, pa2, pa3);
#else
  pv_one<4, 3>(o[3], vb, pa0, pa1, pa2, pa3);
#endif
#pragma unroll
  for (int r = 0; r < 16; ++r) p0[r] = __builtin_amdgcn_exp2f(p0[r]);
}
__device__ __forceinline__ void pv_d0(f32x16* o, int vb, bf16x8 pa0, bf16x8 pa1, bf16x8 pa2, bf16x8 pa3) {
  pv_one<4, 0>(o[0], vb, pa0, pa1, pa2, pa3); pv_one<4, 1>(o[1], vb, pa0, pa1, pa2, pa3); pv_one<4, 2>(o[2], vb, pa0, pa1, pa2, pa3); pv_one<4, 3>(o[3], vb, pa0, pa1, pa2, pa3);
}

#ifdef HANDSCHED
__device__ __forceinline__ bf16x8 perm4(unsigned a0, unsigned a1, unsigned b0, unsigned b1) {
  auto r0 = __builtin_amdgcn_permlane32_swap(a0, b0, false, false); auto r1 = __builtin_amdgcn_permlane32_swap(a1, b1, false, false);
  u32x4 w = {r0[0], r1[0], r0[1], r1[1]}; return __builtin_bit_cast(bf16x8, w); }
__device__ __forceinline__ s16x4 trb(const LAS3 char* p) { return __builtin_amdgcn_ds_read_tr16_b64_v4i16((LAS3 s16x4*)p); }
template <int DK, int QREG, bool SC, class Hook>
__device__ __forceinline__ void hs_step(f32x16& negM, f32x16& n0, f32x16& n1, const LAS3 char* Kl, const bf16x8* qr, const LAS3 char* qls,
                                        f32x16& f0, f32x16& f1, const float alphaPrev, float& l_reg, f32x16* o, const LAS3 char* vb,
                                        float& m_reg, float& mn, float& alpha, const float C, const float thr, float& fC, float& fM, const Hook& hook) {
  constexpr int NS = DK / 16, NSLOT = 2 * NS;
  n0 = f32x16{}; n1 = f32x16{};
  bf16x8 kb0 = *(const LAS3 bf16x8*)(Kl), kb1 = *(const LAS3 bf16x8*)(Kl + 512);
  float s0 = 0.f, s1 = 0.f; unsigned c0[8], c1[8]; bf16x8 pa[4];
#define FIN_SLOT(i) do { \
    if ((i) < 16) { f1[(i) & 15] = SC ? __builtin_amdgcn_exp2f(f1[(i) & 15]) : __builtin_amdgcn_exp2f(fmaf(f1[(i) & 15], fC, fM)); s0 += f0[(i) & 15]; if ((i) > 0) s1 += f1[((i) - 1) & 15]; \
      if ((i) < 8) c0[(i) & 7] = cvtpk(f0[(2 * (i)) & 15], f0[(2 * (i) + 1) & 15]); else if ((i) < 15) c1[((i) - 8) & 7] = cvtpk(f1[(2 * ((i) - 8)) & 15], f1[(2 * ((i) - 8) + 1) & 15]); } \
    if ((i) == 4) pa[0] = perm4(c0[0], c0[1], c0[2], c0[3]); \
    if ((i) == 8) pa[1] = perm4(c0[4], c0[5], c0[6], c0[7]); \
    if ((i) == 12) pa[2] = perm4(c1[0], c1[1], c1[2], c1[3]); \
    if (NSLOT > 16 && (i) == 16) { s1 += f1[15]; c1[7] = cvtpk(f1[14], f1[15]); } \
    if (NSLOT > 16 && (i) == 17) pa[3] = perm4(c1[4], c1[5], c1[6], c1[7]); \
  } while (0)
#pragma unroll
  for (int d0 = 0; d0 < NS; ++d0) {
    bf16x8 nb0 = kb0, nb1 = kb1;
    if (d0 + 1 < NS) { nb0 = *(const LAS3 bf16x8*)(Kl + (d0 + 1) * KDSTR); nb1 = *(const LAS3 bf16x8*)(Kl + (d0 + 1) * KDSTR + 512); }
    bf16x8 q;
    if (d0 < QREG) q = qr[d0]; else q = *(const volatile LAS3 bf16x8*)(qls + (d0 - QREG) * 1024);
#ifdef FILL_FIRST
    FIN_SLOT(2 * d0); SBAR();
    if (SC && d0 == 0) n0 = __builtin_amdgcn_mfma_f32_32x32x16_bf16(kb0, q, negM, 0, 0, 0); else n0 = __builtin_amdgcn_mfma_f32_32x32x16_bf16(kb0, q, n0, 0, 0, 0);
    FIN_SLOT(2 * d0 + 1); SBAR();
    if (SC && d0 == 0) n1 = __builtin_amdgcn_mfma_f32_32x32x16_bf16(kb1, q, negM, 0, 0, 0); else n1 = __builtin_amdgcn_mfma_f32_32x32x16_bf16(kb1, q, n1, 0, 0, 0);
    SBAR();
#else
    if (SC && d0 == 0) n0 = __builtin_amdgcn_mfma_f32_32x32x16_bf16(kb0, q, negM, 0, 0, 0); else n0 = __builtin_amdgcn_mfma_f32_32x32x16_bf16(kb0, q, n0, 0, 0, 0);
    FIN_SLOT(2 * d0); SBAR();
    if (SC && d0 == 0) n1 = __builtin_amdgcn_mfma_f32_32x32x16_bf16(kb1, q, negM, 0, 0, 0); else n1 = __builtin_amdgcn_mfma_f32_32x32x16_bf16(kb1, q, n1, 0, 0, 0);
    FIN_SLOT(2 * d0 + 1); SBAR();
#endif
    kb0 = nb0; kb1 = nb1;
  }
#undef FIN_SLOT
  s16x4 vl[4], vh[4];
#pragma unroll
  for (int ks = 0; ks < 4; ++ks) { vl[ks] = trb(vb + v_rd_off<4>(0, ks, 0)); vh[ks] = trb(vb + v_rd_off<4>(0, ks, 1)); }
  if constexpr (NSLOT <= 16) { s1 += f1[15]; c1[7] = cvtpk(f1[14], f1[15]); pa[3] = perm4(c1[4], c1[5], c1[6], c1[7]); }
  { float ps = s0 + s1; auto rr = __builtin_amdgcn_permlane32_swap(__float_as_uint(ps), __float_as_uint(ps), false, false);
    ps = __uint_as_float(rr[0]) + __uint_as_float(rr[1]); l_reg = l_reg * alphaPrev + ps; }
  SBAR();
  float mA = 0.f, mB = 0.f, pmax = 0.f, mnC = 0.f; bool keep = true;
#define MX3(a, b, c) fmaxf(fmaxf((a), (b)), (c))
#define PART_SLOT(j) do { \
    if ((j) == 0) { mA = MX3(n0[0], n0[1], n0[2]); mA = MX3(mA, n0[3], n0[4]); mB = MX3(n1[0], n1[1], n1[2]); mB = MX3(mB, n1[3], n1[4]); } \
    if ((j) == 1) { mA = MX3(mA, n0[5], n0[6]); mA = MX3(mA, n0[7], n0[8]); mB = MX3(mB, n1[5], n1[6]); mB = MX3(mB, n1[7], n1[8]); } \
    if ((j) == 2) { mA = MX3(mA, n0[9], n0[10]); mA = MX3(mA, n0[11], n0[12]); mB = MX3(mB, n1[9], n1[10]); mB = MX3(mB, n1[11], n1[12]); } \
    if ((j) == 3) { mA = MX3(mA, n0[13], n0[14]); mB = MX3(mB, n1[13], n1[14]); pmax = fmaxf(MX3(mA, mB, n0[15]), n1[15]); } \
    if ((j) == 4) { auto rr = __builtin_amdgcn_permlane32_swap(__float_as_uint(pmax), __float_as_uint(pmax), false, false); \
                    pmax = fmaxf(__uint_as_float(rr[0]), __uint_as_float(rr[1])); keep = SC ? __all(pmax <= thr) : __all(pmax - m_reg <= thr); } \
    if (SC) {   \
      if ((j) == 5) { alpha = 1.f; mn = m_reg; \
        if (!keep) { const float dl_ = fmaxf(pmax, 0.f); n0 = n0 - dl_; n1 = n1 - dl_; alpha = __builtin_amdgcn_exp2f(-dl_); m_reg += dl_; mn = m_reg; \
                     _Pragma("unroll") for (int r_ = 0; r_ < 16; ++r_) negM[r_] = -m_reg; } } \
      if ((j) >= 6 && (j) <= 11) { n0[(2 * ((j) - 6)) & 15] = __builtin_amdgcn_exp2f(n0[(2 * ((j) - 6)) & 15]); n0[(2 * ((j) - 6) + 1) & 15] = __builtin_amdgcn_exp2f(n0[(2 * ((j) - 6) + 1) & 15]); } \
      if ((j) >= 12) { n0[(12 + ((j) - 12)) & 15] = __builtin_amdgcn_exp2f(n0[(12 + ((j) - 12)) & 15]); } \
    } else { \
    if ((j) == 5) { mn = keep ? m_reg : fmaxf(m_reg, pmax); alpha = __builtin_amdgcn_exp2f((m_reg - mn) * C); m_reg = mn; mnC = -mn * C; } \
    if ((j) >= 6 && (j) <= 9) { _Pragma("unroll") for (int r_ = 0; r_ < 4; ++r_) n0[(4 * ((j) - 6) + r_) & 15] = fmaf(n0[(4 * ((j) - 6) + r_) & 15], C, mnC); } \
    if ((j) >= 7 && (j) <= 9) { n0[((j) - 7) & 15] = __builtin_amdgcn_exp2f(n0[((j) - 7) & 15]); } \
    if ((j) >= 10 && (j) <= 14) { n0[(3 + 2 * ((j) - 10)) & 15] = __builtin_amdgcn_exp2f(n0[(3 + 2 * ((j) - 10)) & 15]); n0[(4 + 2 * ((j) - 10)) & 15] = __builtin_amdgcn_exp2f(n0[(4 + 2 * ((j) - 10)) & 15]); } \
    if ((j) == 15) { n0[13] = __builtin_amdgcn_exp2f(n0[13]); n0[14] = __builtin_amdgcn_exp2f(n0[14]); n0[15] = __builtin_amdgcn_exp2f(n0[15]); } \
    } \
    if ((j) >= 6) asm volatile("" : "+v"(n0));     \
  } while (0)
#define PKV(L, H) (bf16x8){L[0], L[1], L[2], L[3], H[0], H[1], H[2], H[3]}
#pragma unroll
  for (int d0 = 0; d0 < 4; ++d0)
#pragma unroll
    for (int ks = 0; ks < 4; ++ks) {
      o[d0] = __builtin_amdgcn_mfma_f32_32x32x16_bf16(pa[ks], PKV(vl[ks], vh[ks]), o[d0], 0, 0, 0);
      if (d0 < 3) { vl[ks] = trb(vb + v_rd_off<4>(d0 + 1, ks, 0)); vh[ks] = trb(vb + v_rd_off<4>(d0 + 1, ks, 1)); }
      PART_SLOT(4 * d0 + ks); hook(4 * d0 + ks); SBAR(); }
#undef PKV
#undef PART_SLOT
#undef MX3
  if constexpr (SC) { fC = 1.f; fM = 0.f; } else { fC = C; fM = mnC; }
}
#endif
template <int DK, int LDQ, int LDK, int LDV, int LDO, int SDEPTH, int QREG>
__device__ __forceinline__ void dense_unit(const bf16_t* __restrict__ Qb, const bf16_t* __restrict__ Kh, const bf16_t* __restrict__ Vh,
                                           const int nt, const int v_first, const int v_last, const float SCALE, bf16_t* __restrict__ Ob, float* __restrict__ part, LAS3 char* lds, const int wave_id) {
  constexpr int SHM_K = (DK / 16) * KDSTR, NKC = DK / 64, CPR = DK / 8;
  constexpr float THRN = 8.f;
#ifdef SRCC
#ifdef SRCC_ALL
  constexpr bool SC = true;
#else
  constexpr bool SC = (DK == 128);
#endif
#else
  constexpr bool SC = false;
#endif
  const float QC = SCALE * LOG2E; const float C = SC ? 1.f : SCALE * LOG2E, thr = SC ? THRN * LOG2E : THRN / SCALE;
  const int wid = wave_id;
  int lane = lane_id_asm();
  const int tid = wid * 64 + lane; int r32 = lane & 31, hi = lane >> 5;
  LAS3 char* V_lds = lds; LAS3 char* K_lds = lds + 2 * SHM_V;
  LAS3 float* ws = (LAS3 float*)(lds + 2 * SHM_V + 2 * SHM_K) + wid * 64; LAS3 float* li_l = ws; LAS3 float* al_l = ws + 32;
  float m_reg = -1e30f, l_reg = 0; f32x16 o[4] = {}; bf16x8 qr[QREG > 0 ? QREG : 1];
  constexpr int NQL = DK / 16 - QREG;
  LAS3 char* qls = lds + 2 * SHM_V + 2 * SHM_K + 2048 + wid * (NQL * 1024) + lane * 16;
  const bf16_t* Qw = Qb + (long)(wid * QBLK + r32) * LDQ + hi * 8;
#pragma unroll
  for (int d0 = 0; d0 < DK / 16; ++d0) { bf16x8 qv = *(const bf16x8*)(Qw + d0 * 16);
    if constexpr (SC)
    { const u32x4 qw = __builtin_bit_cast(u32x4, qv); u32x4 qo;
      qo.x = cvtpk(__uint_as_float(qw.x << 16) * QC, __uint_as_float(qw.x & 0xffff0000u) * QC); qo.y = cvtpk(__uint_as_float(qw.y << 16) * QC, __uint_as_float(qw.y & 0xffff0000u) * QC);
      qo.z = cvtpk(__uint_as_float(qw.z << 16) * QC, __uint_as_float(qw.z & 0xffff0000u) * QC); qo.w = cvtpk(__uint_as_float(qw.w << 16) * QC, __uint_as_float(qw.w & 0xffff0000u) * QC);
      qv = __builtin_bit_cast(bf16x8, qo); }
    if (d0 < QREG) qr[d0] = qv; else *(LAS3 bf16x8*)(qls + (d0 - QREG) * 1024) = qv; }
  const int sr = tid >> 4, sc = (tid & 15) * 8, vst0 = v_st<4>(sr, sc), vst1 = v_st<4>(32 + sr, sc);
  int krow[NKC], kcol[NKC], kst[NKC];
#pragma unroll
  for (int i = 0; i < NKC; ++i) { const int q = tid + 512 * i; krow[i] = q / CPR; kcol[i] = (q % CPR) * 8; kst[i] = kimg(krow[i], q % CPR); }
  int vb0 = (int)(uintptr_t)V_lds + v_rd_base(lane);
#ifdef HANDSCHED
  const LAS3 char* vbp = V_lds + v_rd_base(lane);
#endif
  const LAS3 char* Kl0 = K_lds + hi * KHSTR + r32 * 16;
  bf16x8 svs0[SDEPTH], svs1[SDEPTH], sks[SDEPTH][NKC];
#define SLOAD(i, k0) do { svs0[i] = *(const bf16x8*)(&Vh[(long)((k0) + sr) * LDV + sc]); svs1[i] = *(const bf16x8*)(&Vh[(long)((k0) + 32 + sr) * LDV + sc]); \
    _Pragma("unroll") for (int c_ = 0; c_ < NKC; ++c_) sks[i][c_] = *(const bf16x8*)(&Kh[(long)((k0) + krow[c_]) * LDK + kcol[c_]]); } while (0)
#define SWRITE(b, i) do { *(LAS3 bf16x8*)(V_lds + (b) * SHM_V + vst0) = svs0[i]; *(LAS3 bf16x8*)(V_lds + (b) * SHM_V + vst1) = svs1[i]; \
    _Pragma("unroll") for (int c_ = 0; c_ < NKC; ++c_) *(LAS3 bf16x8*)(K_lds + (b) * SHM_K + kst[c_]) = sks[i][c_]; } while (0)
#define SWAIT() do { if constexpr (SDEPTH == 2) { if constexpr (NKC == 2) asm volatile("s_waitcnt vmcnt(4)" ::: "memory"); else asm volatile("s_waitcnt vmcnt(5)" ::: "memory"); } \
    else asm volatile("s_waitcnt vmcnt(0)" ::: "memory"); } while (0)
#define RESC(a) do { if (__any((a) < 1.f)) { if (hi == 0) al_l[r32] = (a); asm volatile("s_waitcnt lgkmcnt(0)" ::: "memory"); \
    _Pragma("unroll") for (int d = 0; d < 4; ++d) _Pragma("unroll") for (int r = 0; r < 16; ++r) o[d][r] *= al_l[crow(r, hi)]; } } while (0)
  f32x16 pA0, pA1, pB0, pB1; float mnA, mnB, alA, alB; bf16x8 pa0, pa1, pa2, pa3; const int NT = nt;
  constexpr int SE = 0, SO = SDEPTH - 1;
#ifdef PRIO_YOUNG
  if (wid >= 4) __builtin_amdgcn_s_setprio(1);
#endif
#ifdef ONE_BAR
#define SLOADP(i, t) do { const int vt_ = ((t) < NT ? (t) : NT - 1) * KVBLK, kt_ = ((t) + 1 < NT ? (t) + 1 : NT - 1) * KVBLK; \
    svs0[i] = *(const bf16x8*)(&Vh[(long)(vt_ + sr) * LDV + sc]); svs1[i] = *(const bf16x8*)(&Vh[(long)(vt_ + 32 + sr) * LDV + sc]); \
    _Pragma("unroll") for (int c_ = 0; c_ < NKC; ++c_) sks[i][c_] = *(const bf16x8*)(&Kh[(long)(kt_ + krow[c_]) * LDK + kcol[c_]]); } while (0)
#define SWRITEV(vb, i) do { *(LAS3 bf16x8*)(V_lds + (vb) * SHM_V + vst0) = svs0[i]; *(LAS3 bf16x8*)(V_lds + (vb) * SHM_V + vst1) = svs1[i]; } while (0)
#define SWRITEK(kb, i) do { _Pragma("unroll") for (int c_ = 0; c_ < NKC; ++c_) *(LAS3 bf16x8*)(K_lds + (kb) * SHM_K + kst[c_]) = sks[i][c_]; } while (0)
#ifdef VDMA
  static_assert((DK == 128 && SDEPTH == 2) || (DK != 128 && SDEPTH == 1), "VDMA wait counts are written for these two staging depths");
  int vro; { const int kk_ = (wid >> 1) * 8 + ((lane >> 2) & 7), kq_ = (kk_ & ~0xC) | ((kk_ & 4) << 1) | ((kk_ & 8) >> 1); vro = kq_ * LDV + (2 * (wid & 1) + (lane >> 5)) * 32 + (lane & 3) * 8; }
#undef SLOADP
#undef SWRITEV
#define SLOADP(i, t) do { const int kt_ = ((t) + 1 < NT ? (t) + 1 : NT - 1) * KVBLK; \
    _Pragma("unroll") for (int c_ = 0; c_ < NKC; ++c_) sks[i][c_] = *(const bf16x8*)(&Kh[(long)(kt_ + krow[c_]) * LDK + kcol[c_]]); } while (0)
#define SWRITEV(vb, i) do { } while (0)
#define VDMA_ISSUE(vb, t) do { const bf16_t* vg_ = Vh + (long)((t) * KVBLK) * LDV + vro; \
    __builtin_amdgcn_global_load_lds((const unsigned*)vg_, (LAS3 unsigned*)(V_lds + (vb) * SHM_V + wid * 1024), 16, 0, 0); \
    __builtin_amdgcn_global_load_lds((const unsigned*)(vg_ + 32 * LDV), (LAS3 unsigned*)(V_lds + (vb) * SHM_V + 8192 + wid * 1024), 16, 0, 0); } while (0)
#define VMW(n) asm volatile("s_waitcnt vmcnt(" #n ")" ::: "memory")
#ifdef KDMA_A
  constexpr bool KD = (DK != 128);
#else
  constexpr bool KD = false;
#endif
#if 1
  const int kro = lane * LDK + wid * 8;
#define KDMA_ISSUE(kb, t) do { const bf16_t* kg_ = Kh + (long)((t) * KVBLK) * LDK + kro; \
    _Pragma("unroll") for (int i_ = 0; i_ < NKC; ++i_) __builtin_amdgcn_global_load_lds((const unsigned*)(kg_ + 64 * i_), (LAS3 unsigned*)(K_lds + (kb) * SHM_K + ((wid >> 1) + 4 * i_) * KDSTR + (wid & 1) * KHSTR), 16, 0, 0); } while (0)
#endif
#endif
#ifdef VDMA
  if constexpr (KD) { KDMA_ISSUE(0, 0); KDMA_ISSUE(1, 1); VDMA_ISSUE(0, 0); VMW(0);
    __syncthreads(); }
  else {
#pragma unroll
    for (int c_ = 0; c_ < NKC; ++c_) sks[SE][c_] = *(const bf16x8*)(&Kh[(long)krow[c_] * LDK + kcol[c_]]);
    asm volatile("s_waitcnt vmcnt(0)" ::: "memory"); SWRITEK(0, SE);
    VDMA_ISSUE(0, 0);
    SLOADP(SE, 0); if constexpr (SDEPTH == 2) SLOADP(SO, 1);
    __syncthreads();
    if constexpr (SDEPTH == 2) VMW(2); else VMW(0);
    SWRITEK(1, SE); SLOADP(SE, SDEPTH); SBAR(); }
#else
#pragma unroll
  for (int c_ = 0; c_ < NKC; ++c_) sks[SE][c_] = *(const bf16x8*)(&Kh[(long)krow[c_] * LDK + kcol[c_]]);
  asm volatile("s_waitcnt vmcnt(0)" ::: "memory"); SWRITEK(0, SE);
  SLOADP(SE, 0); if constexpr (SDEPTH == 2) SLOADP(SO, 1);
  __syncthreads();
  SWAIT(); SWRITEV(0, SE); SWRITEK(1, SE); SLOADP(SE, SDEPTH); SBAR();
#endif
  qkt<DK, QREG>(pA0, pA1, Kl0, qr, qls); partialSM(pA0, pA1, m_reg, mnA, alA, C, thr, v_first, hi);
  __syncthreads();
#ifdef HANDSCHED
  float fC = 1.f, fM = 0.f;
  f32x16 negM;
#pragma unroll
  for (int r_ = 0; r_ < 16; ++r_) negM[r_] = SC ? -m_reg : 0.f;
#endif
  for (int j = 1; j + 1 < NT; j += 2) {
#ifdef HANDSCHED
#ifdef VDMA
    if constexpr (KD) {
    KDMA_ISSUE(0, j + 1); VDMA_ISSUE(1, j);
    SBAR(); hs_step<DK, QREG, SC>(negM, pB0, pB1, Kl0 + SHM_K, qr, qls, pA0, pA1, alA, l_reg, o, vbp, m_reg, mnB, alB, C, thr, fC, fM,
                              [&](int g) __attribute__((always_inline)) { (void)g; });
    RESC(alB); VMW(0); __syncthreads();
    KDMA_ISSUE(1, j + 2); VDMA_ISSUE(0, j + 1);
    SBAR(); hs_step<DK, QREG, SC>(negM, pA0, pA1, Kl0, qr, qls, pB0, pB1, alB, l_reg, o, vbp + SHM_V, m_reg, mnA, alA, C, thr, fC, fM,
                              [&](int g) __attribute__((always_inline)) { (void)g; });
    RESC(alA); VMW(0); __syncthreads();
    } else {
    if constexpr (DK != 128) { VMW(0); SWRITEK(0, SO); VDMA_ISSUE(1, j); SLOADP(SO, j + SDEPTH); } else { VDMA_ISSUE(1, j); }
    SBAR(); hs_step<DK, QREG, SC>(negM, pB0, pB1, Kl0 + SHM_K, qr, qls, pA0, pA1, alA, l_reg, o, vbp, m_reg, mnB, alB, C, thr, fC, fM,
                              [&](int g) __attribute__((always_inline)) { (void)g; });
    if constexpr (DK == 128) { VMW(4); SWRITEK(0, SO); SLOADP(SO, j + SDEPTH); }
    RESC(alB); if constexpr (DK == 128) VMW(2); else VMW(3);
    __syncthreads();
    if constexpr (DK != 128) { VMW(0); SWRITEK(1, SE); VDMA_ISSUE(0, j + 1); SLOADP(SE, j + 1 + SDEPTH); } else { VDMA_ISSUE(0, j + 1); }
    SBAR(); hs_step<DK, QREG, SC>(negM, pA0, pA1, Kl0, qr, qls, pB0, pB1, alB, l_reg, o, vbp + SHM_V, m_reg, mnA, alA, C, thr, fC, fM,
                              [&](int g) __attribute__((always_inline)) { (void)g; });
    if constexpr (DK == 128) { VMW(4); SWRITEK(1, SE); SLOADP(SE, j + 1 + SDEPTH); }
    RESC(alA); if constexpr (DK == 128) VMW(2); else VMW(3);
    __syncthreads();
    }
#else
    if constexpr (DK != 128) { SWAIT(); SWRITEV(1, SO); SWRITEK(0, SO); SLOADP(SO, j + SDEPTH); }
    SBAR(); hs_step<DK, QREG, SC>(negM, pB0, pB1, Kl0 + SHM_K, qr, qls, pA0, pA1, alA, l_reg, o, vbp, m_reg, mnB, alB, C, thr, fC, fM,
                              [&](int g) __attribute__((always_inline)) { (void)g; });
    if constexpr (DK == 128) { SWAIT(); SWRITEV(1, SO); SWRITEK(0, SO); SLOADP(SO, j + SDEPTH); }
    RESC(alB); __syncthreads();
    if constexpr (DK != 128) { SWAIT(); SWRITEV(0, SE); SWRITEK(1, SE); SLOADP(SE, j + 1 + SDEPTH); }
    SBAR(); hs_step<DK, QREG, SC>(negM, pA0, pA1, Kl0, qr, qls, pB0, pB1, alB, l_reg, o, vbp + SHM_V, m_reg, mnA, alA, C, thr, fC, fM,
                              [&](int g) __attribute__((always_inline)) { (void)g; });
    if constexpr (DK == 128) { SWAIT(); SWRITEV(0, SE); SWRITEK(1, SE); SLOADP(SE, j + 1 + SDEPTH); }
    RESC(alA); __syncthreads();
#endif
#else
    SWAIT(); SWRITEV(1, SO); SWRITEK(0, SO); SLOADP(SO, j + SDEPTH);
    SBAR(); qkt<DK, QREG>(pB0, pB1, Kl0 + SHM_K, qr, qls);
    finishSM(pA0, pA1, alA, l_reg, pa0, pa1, pa2, pa3); interleave_qk_sm<DK / 8, (DK == 128 ? 5 : 4)>(); SBAR();
    pv_sm(o, vb0, pa0, pa1, pa2, pa3, pB0, pB1, m_reg, mnB, alB, C, thr);
    RESC(alB); __syncthreads();
    SWAIT(); SWRITEV(0, SE); SWRITEK(1, SE); SLOADP(SE, j + 1 + SDEPTH);
    SBAR(); qkt<DK, QREG>(pA0, pA1, Kl0, qr, qls);
    finishSM(pB0, pB1, alB, l_reg, pa0, pa1, pa2, pa3); interleave_qk_sm<DK / 8, (DK == 128 ? 5 : 4)>(); SBAR();
    pv_sm(o, vb0 + SHM_V, pa0, pa1, pa2, pa3, pA0, pA1, m_reg, mnA, alA, C, thr);
    RESC(alA); __syncthreads();
#endif
  }
#ifdef VDMA
  VDMA_ISSUE(1, NT - 1);
#else
  SWAIT(); SWRITEV(1, SO);
#endif
#ifdef HANDSCHED
  pA1 = pA1 * fC + fM;
#endif
#undef SLOADP
#undef SWRITEV
#undef SWRITEK
#ifdef VDMA
#undef VDMA_ISSUE
#undef VMW
#undef KDMA_ISSUE
#endif
#else
  SLOAD(SE, 0); asm volatile("s_waitcnt vmcnt(0)" ::: "memory"); SWRITE(0, SE); __syncthreads();
  qkt<DK, QREG>(pA0, pA1, Kl0, qr, qls); partialSM(pA0, pA1, m_reg, mnA, alA, C, thr, v_first, hi);
  SLOAD(SO, KVBLK); if constexpr (SDEPTH == 2) { if (2 < NT) SLOAD(SE, 2 * KVBLK); }
  SWAIT(); SWRITE(1, SO); __syncthreads();
  for (int j = 1; j + 1 < NT; j += 2) {
    SBAR(); qkt<DK, QREG>(pB0, pB1, Kl0 + SHM_K, qr, qls);
    finishSM(pA0, pA1, alA, l_reg, pa0, pa1, pa2, pa3); interleave_qk_sm<DK / 8, (DK == 128 ? 5 : 4)>(); SBAR();
    SLOAD(SO, (j + SDEPTH) * KVBLK); SBAR();
    pv_sm(o, vb0, pa0, pa1, pa2, pa3, pB0, pB1, m_reg, mnB, alB, C, thr);
    __syncthreads(); SWAIT(); SWRITE(0, SE);
    RESC(alB); __syncthreads();
    SBAR(); qkt<DK, QREG>(pA0, pA1, Kl0, qr, qls);
    finishSM(pB0, pB1, alB, l_reg, pa0, pa1, pa2, pa3); interleave_qk_sm<DK / 8, (DK == 128 ? 5 : 4)>(); SBAR();
    if (SDEPTH == 1 || j + 3 < NT) SLOAD(SE, (j + 1 + SDEPTH) * KVBLK); SBAR();
    pv_sm(o, vb0 + SHM_V, pa0, pa1, pa2, pa3, pA0, pA1, m_reg, mnA, alA, C, thr);
    __syncthreads(); SWAIT(); SWRITE(1, SO);
    RESC(alA); __syncthreads();
  }
#endif
  { const int l2 = lane_id_asm();
    lane = l2; r32 = l2 & 31; hi = l2 >> 5; vb0 = (int)(uintptr_t)V_lds + v_rd_base(l2); Kl0 = K_lds + hi * KHSTR + r32 * 16; }
  SBAR(); qkt<DK, QREG>(pB0, pB1, Kl0 + SHM_K, qr, qls);
  finishSM(pA0, pA1, alA, l_reg, pa0, pa1, pa2, pa3); SBAR();
  pv_d0(o, vb0, pa0, pa1, pa2, pa3); partialSM(pB0, pB1, m_reg, mnB, alB, C, thr, v_last, hi);
#if defined(VDMA) && defined(ONE_BAR)
  asm volatile("s_waitcnt vmcnt(0)" ::: "memory");
#endif
  __syncthreads(); RESC(alB);
  finishSM(pB0, pB1, alB, l_reg, pa0, pa1, pa2, pa3); SBAR();
  pv_d0(o, vb0 + SHM_V, pa0, pa1, pa2, pa3);
#ifdef PRIO_YOUNG
  __builtin_amdgcn_s_setprio(0);
#endif
  const int lane_e = lane, r32e = r32, hie = hi, wide = wid;
  if (part == nullptr) {
    if (hie == 0) li_l[r32e] = l_reg; asm volatile("s_waitcnt lgkmcnt(0)" ::: "memory");
    float rli[16];
#pragma unroll
    for (int r = 0; r < 16; ++r) rli[r] = __builtin_amdgcn_rcpf(li_l[crow(r, hie)]);
    bf16_t* Ow = Ob + (long)(wide * QBLK) * LDO;
#pragma unroll
    for (int r = 0; r < 16; ++r) { const int orow = crow(r, hie);
#pragma unroll
      for (int d0 = 0; d0 < 4; ++d0) Ow[(long)orow * LDO + d0 * 32 + r32e] = (bf16_t)(cvtpk(o[d0][r] * rli[r], 0.f) & 0xffffu); }
  } else {
    float* pw = part + (size_t)(wide * QBLK) * 132;
#pragma unroll
    for (int r = 0; r < 16; ++r) { const int orow = crow(r, hie);
#pragma unroll
      for (int d0 = 0; d0 < 4; ++d0) pw[orow * 132 + d0 * 32 + r32e] = o[d0][r]; }
    if (hie == 0) { pw[r32e * 132 + 128] = m_reg; pw[r32e * 132 + 129] = l_reg; }
  }
#undef SLOAD
#undef SWRITE
#undef SWAIT
#undef RESC
}

constexpr int WA_SLOT = 8192, WA_V0 = 7 * WA_SLOT, WA_WS = 14 * WA_SLOT, WA_LDS = WA_WS + 8 * 256;
__device__ __forceinline__ void wattn_unit(const bf16_t* __restrict__ QKV, bf16_t* __restrict__ O, const float* __restrict__ sink, const int g, const int i, LAS3 char* lds, const int wave_id) {
  const int wid = __builtin_amdgcn_readfirstlane(wave_id), lane = lane_id_asm(), tid = wid * 64 + lane, r32 = lane & 31, hi = lane >> 5;
  const int lrow = tid >> 3, c8 = tid & 7;
  bf16x8 kreg[7], vreg[7];
#pragma unroll
  for (int T = 0; T < 7; ++T) {
    int kr;
    if (T < 6) { kr = 128 * i - 128 + 64 * T + lrow; kr = kr < 0 ? 0 : (kr > SEQ - 1 ? SEQ - 1 : kr); }
    else { kr = SEQ + (lrow < 15 ? lrow : 15); }
    const bf16_t* p = QKV + (size_t)kr * C_QKV + 2048 + 64 * g + c8 * 8;
    kreg[T] = *(const bf16x8*)p; vreg[T] = *(const bf16x8*)(p + 256);
  }
  __syncthreads();
  const int kw = lrow * 128 + ((c8 ^ (lrow & 7)) << 4), vw = v_st<2>(lrow, c8 * 8);
#pragma unroll
  for (int T = 0; T < 7; ++T) { *(LAS3 bf16x8*)(lds + T * WA_SLOT + kw) = kreg[T]; *(LAS3 bf16x8*)(lds + WA_V0 + T * WA_SLOT + vw) = vreg[T]; }
  __syncthreads();
  const int hq = 8 * g + wid;
  LAS3 float* al_l = (LAS3 float*)(lds + WA_WS) + wid * 64; LAS3 float* li_l = al_l + 32;
  const float C2 = 0.125f * LOG2E;
  const float sink2 = sink[hq] * LOG2E;
  const int vbase = (int)(uintptr_t)(lds + WA_V0) + v_rd_base(lane);
#ifdef WFAST
  const float thrw = 8.f * LOG2E;
  for (int s = 0; s < 4; ++s) {
    const int q0 = 128 * i + 32 * s, q = q0 + r32;
    bf16x8 qr[4];
#pragma unroll
    for (int d0 = 0; d0 < 4; ++d0) { const bf16x8 qv = *(const bf16x8*)(QKV + (size_t)q * C_QKV + 64 * hq + d0 * 16 + hi * 8);
      const u32x4 qw = __builtin_bit_cast(u32x4, qv); u32x4 qo;
      qo.x = cvtpk(__uint_as_float(qw.x << 16) * C2, __uint_as_float(qw.x & 0xffff0000u) * C2); qo.y = cvtpk(__uint_as_float(qw.y << 16) * C2, __uint_as_float(qw.y & 0xffff0000u) * C2);
      qo.z = cvtpk(__uint_as_float(qw.z << 16) * C2, __uint_as_float(qw.z & 0xffff0000u) * C2); qo.w = cvtpk(__uint_as_float(qw.w << 16) * C2, __uint_as_float(qw.w & 0xffff0000u) * C2);
      qr[d0] = __builtin_bit_cast(bf16x8, qo); }
    float m2 = sink2, l = 1.0f; f32x16 o[2] = {}; f32x16 negM;
#pragma unroll
    for (int r = 0; r < 16; ++r) negM[r] = -m2;
    const int Tlo = s >> 1;
    for (int tt = 0; tt < 6; ++tt) {
      const int T = (tt < 5) ? Tlo + tt : 6;
      const LAS3 char* Ks = lds + T * WA_SLOT;
      f32x16 p0, p1;
#pragma unroll
      for (int d0 = 0; d0 < 4; ++d0) { const int cb = d0 * 2 + hi;
        const bf16x8 b0 = *(const LAS3 bf16x8*)(Ks + r32 * 128 + ((cb ^ (r32 & 7)) << 4));
        const bf16x8 b1 = *(const LAS3 bf16x8*)(Ks + (32 + r32) * 128 + ((cb ^ (r32 & 7)) << 4));
        if (d0 == 0) { p0 = __builtin_amdgcn_mfma_f32_32x32x16_bf16(b0, qr[d0], negM, 0, 0, 0); p1 = __builtin_amdgcn_mfma_f32_32x32x16_bf16(b1, qr[d0], negM, 0, 0, 0); }
        else { p0 = __builtin_amdgcn_mfma_f32_32x32x16_bf16(b0, qr[d0], p0, 0, 0, 0); p1 = __builtin_amdgcn_mfma_f32_32x32x16_bf16(b1, qr[d0], p1, 0, 0, 0); } }
      const int kbase = 128 * i - 128 + 64 * T, off = kbase - q0;
      if (T == 6) {
#pragma unroll
        for (int r = 0; r < 16; ++r) { p0[r] = crow(r, hi) < N_META ? p0[r] : -1e30f; p1[r] = -1e30f; }
      } else if (kbase < 0 || kbase + 63 >= SEQ) {
#pragma unroll
        for (int r = 0; r < 16; ++r) { const int kg0 = kbase + crow(r, hi), kg1 = kg0 + 32;
          p0[r] = (((unsigned)kg0 < (unsigned)SEQ) && ((unsigned)(kg0 - q + 128) <= 256u)) ? p0[r] : -1e30f;
          p1[r] = (((unsigned)kg1 < (unsigned)SEQ) && ((unsigned)(kg1 - q + 128) <= 256u)) ? p1[r] : -1e30f; }
      } else if (off < -97) {
        const int bb = off - r32 + 128 + 4 * hi;
#pragma unroll
        for (int r = 0; r < 16; ++r) { const int cr = (r & 3) + 8 * (r >> 2); p0[r] = (bb + cr >= 0) ? p0[r] : -1e30f; p1[r] = (bb + cr + 32 >= 0) ? p1[r] : -1e30f; }
      } else if (off > 65) {
        const int bb = off - r32 - 128 + 4 * hi;
#pragma unroll
        for (int r = 0; r < 16; ++r) { const int cr = (r & 3) + 8 * (r >> 2); p0[r] = (bb + cr <= 0) ? p0[r] : -1e30f; p1[r] = (bb + cr + 32 <= 0) ? p1[r] : -1e30f; }
      }
      float tmax = fmaxf(p0[0], p1[0]);
#pragma unroll
      for (int r = 1; r < 16; ++r) tmax = fmaxf(tmax, fmaxf(p0[r], p1[r]));
      { auto rr = __builtin_amdgcn_permlane32_swap(__float_as_uint(tmax), __float_as_uint(tmax), false, false);
        tmax = fmaxf(__uint_as_float(rr[0]), __uint_as_float(rr[1])); }
      float alpha = 1.f;
      if (!__all(tmax <= thrw)) {
        const float dl = fmaxf(tmax, 0.f); p0 = p0 - dl; p1 = p1 - dl; alpha = __builtin_amdgcn_exp2f(-dl); m2 += dl;
#pragma unroll
        for (int r = 0; r < 16; ++r) negM[r] = -m2;
        if (hi == 0) al_l[r32] = alpha; asm volatile("s_waitcnt lgkmcnt(0)" ::: "memory");
#pragma unroll
        for (int d = 0; d < 2; ++d)
#pragma unroll
          for (int r = 0; r < 16; ++r) o[d][r] *= al_l[crow(r, hi)];
      }
      float ps = 0.f;
#pragma unroll
      for (int r = 0; r < 16; ++r) { p0[r] = __builtin_amdgcn_exp2f(p0[r]); p1[r] = __builtin_amdgcn_exp2f(p1[r]); ps += p0[r] + p1[r]; }
      { auto rr = __builtin_amdgcn_permlane32_swap(__float_as_uint(ps), __float_as_uint(ps), false, false);
        ps = __uint_as_float(rr[0]) + __uint_as_float(rr[1]); }
      l = l * alpha + ps;
      bf16x8 pa0, pa1, pa2, pa3; packP(p0, p1, pa0, pa1, pa2, pa3);
      const int vb = vbase + T * WA_SLOT;
      pv_one<2, 0>(o[0], vb, pa0, pa1, pa2, pa3); pv_one<2, 1>(o[1], vb, pa0, pa1, pa2, pa3);
    }
#else
  for (int s = 0; s < 4; ++s) {
    const int q0 = 128 * i + 32 * s, q = q0 + r32;
    bf16x8 qr[4];
#pragma unroll
    for (int d0 = 0; d0 < 4; ++d0) qr[d0] = *(const bf16x8*)(QKV + (size_t)q * C_QKV + 64 * hq + d0 * 16 + hi * 8);
    float m2 = sink2, l = 1.0f; f32x16 o[2] = {};
    const int Tlo = s >> 1;
    for (int tt = 0; tt < 6; ++tt) {
      const int T = (tt < 5) ? Tlo + tt : 6;
      const LAS3 char* Ks = lds + T * WA_SLOT;
      f32x16 p0 = f32x16{}, p1 = f32x16{};
#pragma unroll
      for (int d0 = 0; d0 < 4; ++d0) { const int cb = d0 * 2 + hi;
        const bf16x8 b0 = *(const LAS3 bf16x8*)(Ks + r32 * 128 + ((cb ^ (r32 & 7)) << 4));
        const bf16x8 b1 = *(const LAS3 bf16x8*)(Ks + (32 + r32) * 128 + ((cb ^ (r32 & 7)) << 4));
        p0 = __builtin_amdgcn_mfma_f32_32x32x16_bf16(b0, qr[d0], p0, 0, 0, 0);
        p1 = __builtin_amdgcn_mfma_f32_32x32x16_bf16(b1, qr[d0], p1, 0, 0, 0); }
      const int kbase = 128 * i - 128 + 64 * T, off = kbase - q0;
      const bool need_mask = (T == 6) || off < -97 || off > 65 || kbase < 0 || kbase + 63 >= SEQ;
      if (need_mask) {
#pragma unroll
        for (int r = 0; r < 16; ++r) {
          const int kl = crow(r, hi);
          bool v0, v1;
          if (T < 6) { const int kg0 = kbase + kl, kg1 = kg0 + 32;
            v0 = ((unsigned)kg0 < (unsigned)SEQ) && ((unsigned)(kg0 - q + 128) <= 256u);
            v1 = ((unsigned)kg1 < (unsigned)SEQ) && ((unsigned)(kg1 - q + 128) <= 256u); }
          else { v0 = kl < N_META; v1 = false; }
          p0[r] = v0 ? p0[r] : -1e30f; p1[r] = v1 ? p1[r] : -1e30f;
        }
      }
      float tmax = fmaxf(p0[0], p1[0]);
#pragma unroll
      for (int r = 1; r < 16; ++r) tmax = fmaxf(tmax, fmaxf(p0[r], p1[r]));
      { auto rr = __builtin_amdgcn_permlane32_swap(__float_as_uint(tmax), __float_as_uint(tmax), false, false);
        tmax = fmaxf(__uint_as_float(rr[0]), __uint_as_float(rr[1])); }
      const float mnew = fmaxf(m2, tmax * C2), alpha = __builtin_amdgcn_exp2f(m2 - mnew);
      const bool grew = __any(mnew > m2); m2 = mnew;
      float ps = 0.f;
#pragma unroll
      for (int r = 0; r < 16; ++r) { p0[r] = __builtin_amdgcn_exp2f(fmaf(p0[r], C2, -mnew)); p1[r] = __builtin_amdgcn_exp2f(fmaf(p1[r], C2, -mnew)); ps += p0[r] + p1[r]; }
      { auto rr = __builtin_amdgcn_permlane32_swap(__float_as_uint(ps), __float_as_uint(ps), false, false);
        ps = __uint_as_float(rr[0]) + __uint_as_float(rr[1]); }
      l = l * alpha + ps;
      if (grew) {
        if (hi == 0) al_l[r32] = alpha; asm volatile("s_waitcnt lgkmcnt(0)" ::: "memory");
#pragma unroll
        for (int d = 0; d < 2; ++d)
#pragma unroll
          for (int r = 0; r < 16; ++r) o[d][r] *= al_l[crow(r, hi)];
      }
      bf16x8 pa0, pa1, pa2, pa3; packP(p0, p1, pa0, pa1, pa2, pa3);
      const int vb = vbase + T * WA_SLOT;
      pv_one<2, 0>(o[0], vb, pa0, pa1, pa2, pa3); pv_one<2, 1>(o[1], vb, pa0, pa1, pa2, pa3);
    }
#endif
    if (hi == 0) li_l[r32] = l; asm volatile("s_waitcnt lgkmcnt(0)" ::: "memory");
#pragma unroll
    for (int r = 0; r < 16; ++r) { const int orow = crow(r, hi); const float rl = __builtin_amdgcn_rcpf(li_l[orow]);
#pragma unroll
      for (int d0 = 0; d0 < 2; ++d0) O[(size_t)(q0 + orow) * D_MODEL + 64 * hq + d0 * 32 + r32] = (bf16_t)(cvtpk(o[d0][r] * rl, 0.f) & 0xffffu); }
  }
}
#undef SBAR
}
#define GAS __attribute__((address_space(1)))
#define LAS __attribute__((address_space(3)))
typedef GAS unsigned gu32;
#define RLX_AGENT __ATOMIC_RELAXED, __HIP_MEMORY_SCOPE_AGENT
#define LDS_WAIT() asm volatile("s_waitcnt lgkmcnt(0)" ::: "memory")
#define XB_TMO      128
#define XB_XCNT(j)  (256  + 64 * (j))
#define XB_XSUB(j)  (1280 + 64 * (j))
#define XB_XGEN(j)  (2304 + 64 * (j))
#define XB_TOP      3328
#define XB_TOPGEN   3392
#define XCD_BAR_WORDS 3456
#define XB_SPIN_CAP (1u << 18)

__device__ __forceinline__ unsigned xb_ld(unsigned* p)              { return __hip_atomic_load(p, __ATOMIC_RELAXED, __HIP_MEMORY_SCOPE_AGENT); }
__device__ __forceinline__ unsigned xb_add(unsigned* p, unsigned v) { return __hip_atomic_fetch_add(p, v, __ATOMIC_RELAXED, __HIP_MEMORY_SCOPE_AGENT); }
__device__ __forceinline__ unsigned xb_xcc_id() { return (unsigned)__builtin_amdgcn_s_getreg((3 << 11) | 20) & 0xFu; }
#define XB_SPIN(cond, bar) do { unsigned _sp = 0; while (cond) { __builtin_amdgcn_s_sleep(1); \
    if ((++_sp & 255u) == 0u) { if (xb_ld(&(bar)[XB_TMO])) break; if (_sp > XB_SPIN_CAP) { atomicAdd(&(bar)[XB_TMO], 1u); break; } } } } while (0)

struct XcdBarrier {
    unsigned* bar; unsigned x;
    volatile LAS unsigned* st;
};

__device__ __forceinline__ XcdBarrier xcd_barrier_post(unsigned* bar, volatile LAS unsigned* st, const bool t0  ) {
    XcdBarrier b; b.bar = bar; b.x = xb_xcc_id(); b.st = st;
    if (t0) (void)xb_add(&bar[XB_XCNT(b.x)], 1u);
    return b;
}
__device__ __forceinline__ void xcd_barrier_complete(unsigned* bar, unsigned x, unsigned& nloc, unsigned& nx) {
    const unsigned G = gridDim.x * gridDim.y * gridDim.z;
    unsigned sum, cnt, mine, sp = 0u;
    for (;;) {
        sum = 0u; cnt = 0u; mine = 0u;
#pragma unroll
        for (unsigned j = 0; j < 16; ++j) { const unsigned c = xb_ld(&bar[XB_XCNT(j)]); sum += c; cnt += (c > 0u) ? 1u : 0u; mine = (j == x) ? c : mine; }
        if (sum == G) break;
        __builtin_amdgcn_s_sleep(1);
        if ((++sp & 255u) == 0u) { if (xb_ld(&bar[XB_TMO])) break; if (sp > XB_SPIN_CAP) { atomicAdd(&bar[XB_TMO], 1u); break; } }
    }
    nloc = mine > 0u ? mine : 1u; nx = cnt > 0u ? cnt : 1u;
}

__device__ __forceinline__ void xcd_barrier(const XcdBarrier& b, const bool t0  ) {
    asm volatile("s_waitcnt vmcnt(0)" ::: "memory");
    __syncthreads();
    if (t0) {
        unsigned* bar = b.bar;
        __builtin_amdgcn_s_waitcnt(0);
        unsigned nloc = b.st[0], nx = b.st[1];
        if (nloc == 0u) { xcd_barrier_complete(bar, b.x, nloc, nx); b.st[0] = nloc; b.st[1] = nx; }
        const unsigned old = xb_add(&bar[XB_XSUB(b.x)], 1u);
        const unsigned gen = old / nloc;
        if (old + 1u == (gen + 1u) * nloc) {
            __builtin_amdgcn_fence(__ATOMIC_RELEASE, "agent");
            asm volatile("s_waitcnt vmcnt(0)" ::: "memory");
            const unsigned og = xb_add(&bar[XB_TOP], 1u);
            const unsigned tg = og / nx;
            if (og + 1u == (tg + 1u) * nx) xb_add(&bar[XB_TOPGEN], 1u);
            else XB_SPIN(xb_ld(&bar[XB_TOPGEN]) == tg, bar);
            __builtin_amdgcn_fence(__ATOMIC_ACQUIRE, "agent");
            xb_add(&bar[XB_XGEN(b.x)], 1u);
            asm volatile("s_waitcnt vmcnt(0)" ::: "memory");
        } else {
            XB_SPIN(xb_ld(&bar[XB_XGEN(b.x)]) == gen, bar);
            __builtin_amdgcn_fence(__ATOMIC_ACQUIRE, "agent");
            asm volatile("s_waitcnt vmcnt(0)" ::: "memory");
        }
    }
    __syncthreads();
}
constexpr int NWAVES = 8;
constexpr size_t MiB = 1u << 20, KiB = 1u << 10;
constexpr size_t WS_CTL = 0, CTL_ZERO_BYTES = 1 * MiB;
constexpr size_t TAB32 = 2304 * KiB;
constexpr size_t WS_AC = 1 * MiB, WS_AS = WS_AC + TAB32, WS_ROWC = WS_AS + TAB32, WS_ROWS = WS_ROWC + TAB32, WS_COLC = WS_ROWS + TAB32, WS_COLS = WS_COLC + TAB32;
constexpr size_t WS_CC = WS_COLS + TAB32, WS_CS = WS_CC + 768 * KiB, WS_TABEND = WS_CS + 768 * KiB;
static_assert((size_t)MPAD * 32 * 4 <= TAB32 && (size_t)MPAD * 8 * 4 <= 768 * KiB && WS_TABEND <= 16 * MiB, "tables");
constexpr size_t WS_BIASP = 16 * MiB, WS_BLKE = WS_BIASP + 64 * KiB, WS_WGBASE = WS_BLKE + 64 * KiB, WS_TOKINFO = 16 * MiB + 256 * KiB, WS_TOKDEST = 17 * MiB, WS_PART = 17 * MiB + 512 * KiB;
static_assert(WS_TOKINFO + (size_t)SEQ * 32 <= WS_TOKDEST && WS_TOKDEST + (size_t)SEQ * 16 <= WS_PART && WS_PART + (size_t)256 * 16 * 132 * 4 <= 20 * MiB, "small buffers");
constexpr size_t WS_W_IN = 20 * MiB, WS_W_QB = WS_W_IN + 10 * MiB, WS_W_KVB = WS_W_QB + 1536 * KiB, WS_W_OUT = WS_W_KVB + 1 * MiB, WS_W_GU = WS_W_OUT + 8 * MiB,
                 WS_W_DN = WS_W_GU + 56 * MiB, WS_W_QKV = WS_W_DN + 28 * MiB, WS_W_CO = WS_W_QKV + 10 * MiB, WS_W_MGU = WS_W_CO + 8 * MiB, WS_W_MDN = WS_W_MGU + 448 * MiB, WS_W_END = WS_W_MDN + 224 * MiB;
static_assert(WS_W_END <= 816 * MiB, "weights");
constexpr size_t WS_H = 816 * MiB, WS_A = 946 * MiB;
constexpr size_t WS_Z = 1011 * MiB, WS_CQN = 1093 * MiB, WS_CKVN = 1110 * MiB, WS_QA = 1119 * MiB, WS_KA = 1168 * MiB, WS_VA = 1217 * MiB, WS_QB = 1250 * MiB, WS_KB = 1283 * MiB;
constexpr size_t WS_O = 1292 * MiB, WS_Y = 1357 * MiB, WS_ACT = 1487 * MiB;
constexpr size_t WS_QKV = WS_Z;
constexpr size_t WS_XS = 1011 * MiB, WS_Y2 = 1147 * MiB, WS_ACT2 = 1283 * MiB, WS_VB = 1760 * MiB, WS_YP = 1770 * MiB, WS_END = 1786 * MiB;
static_assert(WS_Z + (size_t)MPAD * ZLD * 2 <= WS_CQN && WS_CQN + (size_t)MPAD * 512 * 2 <= WS_CKVN && WS_CKVN + (size_t)MPAD * 256 * 2 <= WS_QA && WS_QA + (size_t)MPAD * QA_LD * 2 <= WS_KA &&
              WS_KA + (size_t)MPAD * QA_LD * 2 <= WS_VA && WS_VA + (size_t)MPAD * VA_LD * 2 <= WS_QB && WS_QB + (size_t)MPAD * QB_LD * 2 <= WS_KB && WS_KB + (size_t)MPAD * KB_LD * 2 <= WS_O &&
              WS_O + (size_t)MPAD * 2048 * 2 <= WS_Y && WS_Y + (size_t)MPAD * 2048 * 4 <= WS_ACT && WS_ACT + (size_t)MPAD * D_FF * 2 <= WS_VB && WS_VB + (size_t)MPAD * KB_LD * 2 <= WS_YP && WS_YP + (size_t)8 * 256 * 2048 * 4 <= WS_END && WS_H + (size_t)MPAD * 2048 * 4 <= WS_A &&
              WS_A + (size_t)MPAD * 2048 * 2 <= WS_Z && WS_XS + (size_t)MOE_ROWS * 2048 * 2 <= WS_Y2 && WS_Y2 + (size_t)MOE_ROWS * 2048 * 2 <= WS_ACT2 && WS_ACT2 + (size_t)MOE_ROWS * D_FF * 2 <= WS_VB, "d_ws map");
constexpr int CW_BAR = 4096, CW_CNT = 8192, CW_NBLK = CW_CNT + 64 * 8;
constexpr int RING_BYTES = 143360, LDSCTL_OFF = RING_BYTES, MISC_OFF = LDSCTL_OFF + 320, LDS_BYTES = 147456;
static_assert(att::WA_LDS <= RING_BYTES, "wattn LDS");

__device__ __forceinline__ float wave_sum(float v) {
#pragma unroll
    for (int o = 1; o < 64; o <<= 1) v += __shfl_xor(v, o);
    return v;
}
struct Ctx { LAS unsigned char* lds; int tid, lane, wave, vcu, G; };

enum { TM_PLAIN = 0, TM_QB = 1, TM_GATE = 2, TM_UP = 3, TM_QKV = 4 };
template <int MODE> __device__ __forceinline__ int tr_dest_row(int n) {
    if (MODE == TM_QB)   { const int h = n / 192, d = n % 192; if (d < 128) return n; const int j = d - 128; return h * 192 + 128 + 2 * (j & 31) + (j >> 5); }
    if (MODE == TM_GATE) { return 256 * (n >> 7) + (n & 127); }
    if (MODE == TM_UP)   { return 256 * (n >> 7) + 128 + (n & 127); }
    if (MODE == TM_QKV)  { const int hd = n >> 6, d = n & 63; if (hd < 36 && d < 16) return hd * 64 + 2 * (d & 7) + (d >> 3); return n; }
    return n;
}
template <int MODE, bool TILED = false, bool FP8 = false> __device__ __forceinline__ void transpose_item(const float* __restrict__ W, int K, int N, bf16_t* __restrict__ WT, LAS float* scr, int item, int lane, float wscale = 1.f) {
    const int nblk = N >> 5, kb = item / nblk, nb = item - kb * nblk, k0 = 64 * kb, n0 = 32 * nb;
    const int n4 = (lane & 7) * 4, kk = lane >> 3;
    f32x4 v[8];
#pragma unroll
    for (int it = 0; it < 8; ++it) v[it] = __builtin_nontemporal_load((const f32x4*)(W + (size_t)(k0 + 8 * it + kk) * N + n0 + n4));
#pragma unroll
    for (int it = 0; it < 8; ++it) { const int k = 8 * it + kk;
        scr[(n4 + 0) * 65 + k] = v[it][0]; scr[(n4 + 1) * 65 + k] = v[it][1]; scr[(n4 + 2) * 65 + k] = v[it][2]; scr[(n4 + 3) * 65 + k] = v[it][3]; }
    LDS_WAIT(); asm volatile("" ::: "memory");
    const int c = lane & 7;
#pragma unroll
    for (int j = 0; j < 4; ++j) { const int n = (lane >> 3) + 8 * j; const LAS float* s = scr + n * 65 + 8 * c;
        const int dr = tr_dest_row<MODE>(n0 + n);
        if constexpr (FP8) {
            u32x2 o; o.x = pkf8x4(s[0] * wscale, s[1] * wscale, s[2] * wscale, s[3] * wscale); o.y = pkf8x4(s[4] * wscale, s[5] * wscale, s[6] * wscale, s[7] * wscale);
            unsigned char* p = (unsigned char*)WT + ((size_t)(dr >> 8) * (K >> 7) + (k0 >> 7)) * 32768 + (dr & 255) * 128 + (k0 & 127) + 8 * c;
            __builtin_nontemporal_store(o, (u32x2*)p);
        } else {
        u32x4 o; o.x = pkbf(s[0], s[1]); o.y = pkbf(s[2], s[3]); o.z = pkbf(s[4], s[5]); o.w = pkbf(s[6], s[7]);
        bf16_t* p = TILED ? WT + ((size_t)(dr >> 8) * (K >> 6) + kb) * 16384 + (dr & 255) * 64 + 8 * c : WT + (size_t)dr * K + k0 + 8 * c;
        if (TILED || MODE == TM_GATE || MODE == TM_UP) __builtin_nontemporal_store(o, (u32x4*)p); else *(u32x4*)p = o; } }
    LDS_WAIT(); asm volatile("" ::: "memory");
}
__device__ __forceinline__ void tw_load(const float* __restrict__ W, int N, int item, int lane, f32x4 (&v)[16]) {
    const int nblk = N >> 5, kb = item / nblk, nb = item - kb * nblk, k0 = 128 * kb, n0 = 32 * nb;
    const int n4 = (lane & 7) * 4, kk = lane >> 3;
#pragma unroll
    for (int it = 0; it < 16; ++it) v[it] = __builtin_nontemporal_load((const f32x4*)(W + (size_t)(k0 + 16 * kk + it) * N + n0 + n4));
}
template <int MODE, bool TILED, bool FP8> __device__ __forceinline__ void tw_store(const f32x4 (&v)[16], int K, int N, bf16_t* __restrict__ WT, LAS float* scr, int item, int lane, float wscale = 1.f) {
    const int nblk = N >> 5, kb = item / nblk, nb = item - kb * nblk, k0 = 128 * kb, n0 = 32 * nb;
    const int n4 = (lane & 7) * 4, kk = lane >> 3;
    (void)scr;
#pragma unroll
    for (int i = 0; i < 4; ++i) {
        const int dr = tr_dest_row<MODE>(n0 + n4 + i);
        if constexpr (FP8) {
            u32x4 o; o.x = pkf8x4(v[0][i] * wscale, v[1][i] * wscale, v[2][i] * wscale, v[3][i] * wscale); o.y = pkf8x4(v[4][i] * wscale, v[5][i] * wscale, v[6][i] * wscale, v[7][i] * wscale);
            o.z = pkf8x4(v[8][i] * wscale, v[9][i] * wscale, v[10][i] * wscale, v[11][i] * wscale); o.w = pkf8x4(v[12][i] * wscale, v[13][i] * wscale, v[14][i] * wscale, v[15][i] * wscale);
            unsigned char* p = (unsigned char*)WT + ((size_t)(dr >> 8) * (K >> 7) + kb) * 32768 + (dr & 255) * 128 + 16 * kk;
            __builtin_nontemporal_store(o, (u32x4*)p);
        } else {
            u32x4 o0, o1; o0.x = pkbf(v[0][i], v[1][i]); o0.y = pkbf(v[2][i], v[3][i]); o0.z = pkbf(v[4][i], v[5][i]); o0.w = pkbf(v[6][i], v[7][i]);
            o1.x = pkbf(v[8][i], v[9][i]); o1.y = pkbf(v[10][i], v[11][i]); o1.z = pkbf(v[12][i], v[13][i]); o1.w = pkbf(v[14][i], v[15][i]);
            const int kq = k0 + 16 * kk;
            bf16_t* p = TILED ? WT + ((size_t)(dr >> 8) * (K >> 6) + (kq >> 6)) * 16384 + (dr & 255) * 64 + (kq & 63) : WT + (size_t)dr * K + kq;
            __builtin_nontemporal_store(o0, (u32x4*)p); __builtin_nontemporal_store(o1, (u32x4*)(p + 8)); }
    }
}
__device__ const float INVF_A[32] = {1.000000000e+00f, 6.636012793e-01f, 4.403665960e-01f, 2.922278047e-01f, 1.939227432e-01f, 1.286873668e-01f, 8.539710194e-02f, 5.666962266e-02f, 3.760603070e-02f, 2.495540865e-02f, 1.656043902e-02f, 1.098952908e-02f, 7.292664610e-03f, 4.839421250e-03f, 3.211445874e-03f, 2.131119603e-03f, 1.414213562e-03f, 9.384738514e-04f, 6.227723788e-04f, 4.132725589e-04f, 2.742481884e-04f, 1.819914323e-04f, 1.207697351e-04f, 8.014294872e-05f, 5.318296098e-05f, 3.529227615e-05f, 2.341999971e-05f, 1.554154005e-05f, 1.031338616e-05f, 6.843975370e-06f, 4.541670478e-06f, 3.013858077e-06f};
__device__ const float INVF_C[8] = {1.000000000e+00f, 1.939227432e-01f, 3.760603070e-02f, 7.292664610e-03f, 1.414213562e-03f, 2.742481884e-04f, 5.318296098e-05f, 1.031338616e-05f};
__device__ const float INVF_X[32] = {1.000000000e+00f, 7.498942614e-01f, 5.623413324e-01f, 4.216965139e-01f, 3.162277639e-01f, 2.371373773e-01f, 1.778279394e-01f, 1.333521307e-01f, 1.000000015e-01f, 7.498941571e-02f, 5.623413250e-02f, 4.216965288e-02f, 3.162277490e-02f, 2.371373773e-02f, 1.778279431e-02f, 1.333521493e-02f, 9.999999776e-03f, 7.498941850e-03f, 5.623413250e-03f, 4.216964822e-03f, 3.162277630e-03f, 2.371373586e-03f, 1.778279431e-03f, 1.333521446e-03f, 1.000000047e-03f, 7.498942432e-04f, 5.623413017e-04f, 4.216965172e-04f, 3.162277571e-04f, 2.371373703e-04f, 1.778279402e-04f, 1.333521504e-04f};
__device__ __forceinline__ void sincos_f32ang(float ang, float& s, float& c) {
    const double x = (double)ang;
    const double q = __builtin_rint(x * 0.63661977236758134308);
    double t = __builtin_fma(-q, 1.57079632679489655800e+00, x);
    t = __builtin_fma(-q, 6.12323399573676603587e-17, t);
    const double t2 = t * t;
    const double sp = t * (1.0 + t2 * (-1.0 / 6.0 + t2 * (1.0 / 120.0 + t2 * (-1.0 / 5040.0 + t2 * (1.0 / 362880.0 + t2 * (-1.0 / 39916800.0 + t2 * (1.0 / 6227020800.0)))))));
    const double cp = 1.0 + t2 * (-0.5 + t2 * (1.0 / 24.0 + t2 * (-1.0 / 720.0 + t2 * (1.0 / 40320.0 + t2 * (-1.0 / 3628800.0 + t2 * (1.0 / 479001600.0 + t2 * (-1.0 / 87178291200.0)))))));
    const int qi = (int)q & 3;
    const double sv = (qi == 0) ? sp : (qi == 1) ? cp : (qi == 2) ? -sp : -cp;
    const double cv = (qi == 0) ? cp : (qi == 1) ? -sp : (qi == 2) ? -cp : sp;
    s = (float)sv; c = (float)cv;
}
__device__ __forceinline__ int tok_pos(int r) { return r < SEQ ? r + N_META : (r < L_TOK ? r - SEQ : 0); }

struct Args { const float* in[30]; float* out; unsigned char* ws; int ph_lo, ph_hi; };
typedef __attribute__((address_space(4))) const unsigned long long karg_u64;
__device__ __forceinline__ unsigned long long karg_load(int idx) { asm volatile("" : "+s"(idx)); return ((karg_u64*)__builtin_amdgcn_kernarg_segment_ptr())[idx]; }
__device__ __forceinline__ const float* in_ptr(const Args&, int i) { return (const float*)(GAS const float*)karg_load(i); }
__device__ __forceinline__ unsigned char* ws_ptr(const Args&) { return (unsigned char*)(GAS unsigned char*)karg_load(31); }
static_assert(offsetof(Args, in) == 0 && offsetof(Args, out) == 240 && offsetof(Args, ws) == 248, "Args layout vs karg_load");
enum { I_X = 0, I_META, I_EATTN_PRE, I_EATTN_POST, I_W_IN, I_AQN, I_WQB, I_AKVN, I_WKVB, I_BQN, I_BKN, I_EW_OUT, I_EFFN_PRE, I_EFFN_POST, I_FG, I_FU, I_FD,
       I_OATTN_PRE, I_OATTN_POST, I_CWQKV, I_CBQKV, I_CSINK, I_CWOUT, I_CBOUT, I_OFFN_PRE, I_OFFN_POST, I_ROUTER, I_MG, I_MU, I_MD };

constexpr int CVT_NITEMS = 9 * (2 * 16 * 224 + 56 * 64), CVT_RX1 = 118 * 40, CVT_RX11 = 126 * 40;
__device__ __forceinline__ void cvt_big(const Ctx& F, const Args& a, const int lo, const int hi, const int worker, const int nworkers) {
    unsigned char* ws = ws_ptr(a);
    LAS float* scr = nullptr;
    const int gw = worker * NWAVES + F.wave, NGW = nworkers * NWAVES;
    constexpr int IT_FF = 16 * 224, IT_DN = 56 * 64;
    const int NITEMS = hi;
#define CVT_DECODE(it_, kind_, e_, r_) do { int q_ = (it_); kind_ = 0; e_ = 0; \
        if (q_ >= IT_FF) { q_ -= IT_FF; kind_ = 1; if (q_ >= IT_FF) { q_ -= IT_FF; kind_ = 2; if (q_ >= IT_DN) { q_ -= IT_DN; kind_ = 3; if (q_ >= 8 * IT_FF) { q_ -= 8 * IT_FF; kind_ = 4; if (q_ >= 8 * IT_FF) { q_ -= 8 * IT_FF; kind_ = 5; } } \
            if (kind_ == 5) { e_ = q_ / IT_DN; q_ -= e_ * IT_DN; } else { e_ = q_ / IT_FF; q_ -= e_ * IT_FF; } } } } r_ = q_; } while (0)
#define CVT_LOAD(kind_, e_, r_, v_) do { \
        const float* w_ = kind_ == 0 ? in_ptr(a, I_FG) : kind_ == 1 ? in_ptr(a, I_FU) : kind_ == 2 ? in_ptr(a, I_FD) : kind_ == 3 ? in_ptr(a, I_MG) + (size_t)e_ * 2048 * D_FF : kind_ == 4 ? in_ptr(a, I_MU) + (size_t)e_ * 2048 * D_FF : in_ptr(a, I_MD) + (size_t)e_ * D_FF * 2048; \
        tw_load(w_, (kind_ == 2 || kind_ == 5) ? 2048 : D_FF, r_, lane, v_); } while (0)
#define CVT_STORE(kind_, e_, r_, v_) do { \
        if (kind_ == 0) tw_store<TM_GATE, false, false>(v_, 2048, D_FF, (bf16_t*)(ws + WS_W_GU), scr, r_, lane); \
        else if (kind_ == 1) tw_store<TM_UP, false, false>(v_, 2048, D_FF, (bf16_t*)(ws + WS_W_GU), scr, r_, lane); \
        else if (kind_ == 2) tw_store<TM_PLAIN, true, false>(v_, D_FF, 2048, (bf16_t*)(ws + WS_W_DN), scr, r_, lane); \
        else if (kind_ == 3) tw_store<TM_GATE, true, true>(v_, 2048, D_FF, (bf16_t*)(ws + WS_W_MGU + (size_t)e_ * 2 * D_FF * 2048), scr, r_, lane, SC_WGU); \
        else if (kind_ == 4) tw_store<TM_UP, true, true>(v_, 2048, D_FF, (bf16_t*)(ws + WS_W_MGU + (size_t)e_ * 2 * D_FF * 2048), scr, r_, lane, SC_WGU); \
        else tw_store<TM_PLAIN, true, true>(v_, D_FF, 2048, (bf16_t*)(ws + WS_W_MDN + (size_t)e_ * 2048 * D_FF), scr, r_, lane, SC_WDN); } while (0)
    const int lane = F.lane;
    f32x4 va[16], vb[16];
    int it = lo + gw, ka = 0, ea = 0, ra = 0, kb_ = 0, eb = 0, rb = 0;
    if (it < NITEMS) { CVT_DECODE(it, ka, ea, ra); CVT_LOAD(ka, ea, ra, va); }
    while (it < NITEMS) {
        int nx = it + NGW;
        if (nx < NITEMS) { CVT_DECODE(nx, kb_, eb, rb); CVT_LOAD(kb_, eb, rb, vb); }
        CVT_STORE(ka, ea, ra, va);
        it = nx; if (it >= NITEMS) break;
        nx = it + NGW;
        if (nx < NITEMS) { CVT_DECODE(nx, ka, ea, ra); CVT_LOAD(ka, ea, ra, va); }
        CVT_STORE(kb_, eb, rb, vb);
        it = nx;
    }
#undef CVT_DECODE
#undef CVT_LOAD
#undef CVT_STORE
}
__device__ __forceinline__ void p0_prologue(const Ctx& F, const Args& a) {
    unsigned char* ws = ws_ptr(a);
    LAS float* scr = (LAS float*)(F.lds + F.wave * 8448);
    const int gw = F.vcu * NWAVES + F.wave, NGW = F.G * NWAVES;
    constexpr int IT_IN = 32 * 74, IT_QB = 8 * 48, IT_KVB = 4 * 64, IT_OUT = 32 * 64, IT_QKV = 32 * 80;
    constexpr int NITEMS = IT_IN + IT_QB + IT_KVB + IT_OUT + IT_QKV + IT_OUT;
    for (int it = gw; it < NITEMS; it += NGW) {
        int r = it;
        if (r < IT_IN)  { transpose_item<TM_PLAIN>(in_ptr(a, I_W_IN), 2048, EVEN_IN, (bf16_t*)(ws + WS_W_IN), scr, r, F.lane); continue; } r -= IT_IN;
        if (r < IT_QB)  { transpose_item<TM_QB>(in_ptr(a, I_WQB), 512, 1536, (bf16_t*)(ws + WS_W_QB), scr, r, F.lane); continue; } r -= IT_QB;
        if (r < IT_KVB) { transpose_item<TM_PLAIN>(in_ptr(a, I_WKVB), 256, 2048, (bf16_t*)(ws + WS_W_KVB), scr, r, F.lane); continue; } r -= IT_KVB;
        if (r < IT_OUT) { transpose_item<TM_PLAIN>(in_ptr(a, I_EW_OUT), 2048, 2048, (bf16_t*)(ws + WS_W_OUT), scr, r, F.lane); continue; } r -= IT_OUT;
        if (r < IT_QKV) { transpose_item<TM_QKV>(in_ptr(a, I_CWQKV), 2048, C_QKV, (bf16_t*)(ws + WS_W_QKV), scr, r, F.lane); continue; } r -= IT_QKV;
        transpose_item<TM_PLAIN>(in_ptr(a, I_CWOUT), 2048, 2048, (bf16_t*)(ws + WS_W_CO), scr, r, F.lane);
    }
    const int gt = gw * 64 + F.lane, NGT = NGW * 64;
    { u32x4* zp = (u32x4*)((bf16_t*)(ws + WS_W_IN) + (size_t)EVEN_IN * 2048);
      for (int i = gt; i < 192 * 2048 / 8; i += NGT) zp[i] = (u32x4){0u, 0u, 0u, 0u}; }
    const float* gpre = in_ptr(a, I_EATTN_PRE);
    for (int m = gw; m < MPAD; m += NGW) {
        bf16_t* orow = (bf16_t*)(ws + WS_A) + (size_t)m * 2048;
        if (m >= L_TOK) {
#pragma unroll
            for (int j = 0; j < 4; ++j) *(u32x4*)(orow + 512 * j + 8 * F.lane) = (u32x4){0u, 0u, 0u, 0u};
            continue; }
        const float* src = m < SEQ ? in_ptr(a, I_X) + (size_t)m * 2048 : in_ptr(a, I_META) + (size_t)(m - SEQ) * 2048;
        f32x4 v[4][2]; float ss = 0.f;
#pragma unroll
        for (int j = 0; j < 4; ++j)
#pragma unroll
            for (int q = 0; q < 2; ++q) { v[j][q] = *(const f32x4*)(src + 512 * j + 8 * F.lane + 4 * q); ss += (v[j][q][0] * v[j][q][0] + v[j][q][1] * v[j][q][1]) + (v[j][q][2] * v[j][q][2] + v[j][q][3] * v[j][q][3]); }
        const float rs = rsqrtf(wave_sum(ss) * (1.0f / 2048.0f) + RMS_EPS);
#pragma unroll
        for (int j = 0; j < 4; ++j) { const f32x4 g0 = *(const f32x4*)(gpre + 512 * j + 8 * F.lane), g1 = *(const f32x4*)(gpre + 512 * j + 8 * F.lane + 4);
            const f32x4 x0 = v[j][0] * rs * g0, x1 = v[j][1] * rs * g1;
            u32x4 w; w.x = pkbf(x0[0], x0[1]); w.y = pkbf(x0[2], x0[3]); w.z = pkbf(x1[0], x1[1]); w.w = pkbf(x1[2], x1[3]);
            *(u32x4*)(orow + 512 * j + 8 * F.lane) = w; }
    }
    for (int idx = gt; idx < MPAD * 32; idx += NGT) {
        const int r = idx >> 5, i = idx & 31;
        const float invA = INVF_A[i], invX = INVF_X[i];
        const float angA = (float)tok_pos(r) * invA;
        const int grow = r < SEQ ? (r >> 6) : -1, gcol = r < SEQ ? (r & 63) : (r < L_TOK ? r - SEQ : 0);
        const float angR = (float)grow * invX, angC = (float)gcol * invX;
        float sn, cs;
        sincos_f32ang(angA, sn, cs); ((float*)(ws + WS_AC))[idx] = cs; ((float*)(ws + WS_AS))[idx] = sn;
        sincos_f32ang(angR, sn, cs); ((float*)(ws + WS_ROWC))[idx] = cs; ((float*)(ws + WS_ROWS))[idx] = sn;
        sincos_f32ang(angC, sn, cs); ((float*)(ws + WS_COLC))[idx] = cs; ((float*)(ws + WS_COLS))[idx] = sn;
    }
    for (int idx = gt; idx < MPAD * 8; idx += NGT) {
        const int r = idx >> 3, i = idx & 7;
        const float ang = (float)tok_pos(r) * INVF_C[i];
        float sn, cs; sincos_f32ang(ang, sn, cs);
        ((float*)(ws + WS_CC))[idx] = cs; ((float*)(ws + WS_CS))[idx] = sn;
    }
    for (int n = gt; n < C_QKV; n += NGT) ((float*)(ws + WS_BIASP))[tr_dest_row<TM_QKV>(n)] = in_ptr(a, I_CBQKV)[n];
}

__device__ __forceinline__ void p2_postz(const Ctx& F, const Args& a) {
    unsigned char* ws = ws_ptr(a);
    const int gw = F.vcu * NWAVES + F.wave, NGW = F.G * NWAVES, lane = F.lane;
    const bf16_t* Z = (const bf16_t*)(ws + WS_Z);
    bf16_t* CQN = (bf16_t*)(ws + WS_CQN); bf16_t* CKVN = (bf16_t*)(ws + WS_CKVN); bf16_t* KA = (bf16_t*)(ws + WS_KA); bf16_t* QB = (bf16_t*)(ws + WS_QB); bf16_t* KB = (bf16_t*)(ws + WS_KB); bf16_t* VB = (bf16_t*)(ws + WS_VB);
    const float* AC = (const float*)(ws + WS_AC); const float* AS = (const float*)(ws + WS_AS);
    const float* tc = (const float*)(ws + (lane < 32 ? WS_ROWC : WS_COLC)); const float* ts = (const float*)(ws + (lane < 32 ? WS_ROWS : WS_COLS));
    const int d1 = lane + (lane >= 32 ? 32 : 0), d2 = d1 + 32, ti = lane & 31;
    const f32x4 gq0 = *(const f32x4*)(in_ptr(a, I_AQN) + 8 * lane), gq1 = *(const f32x4*)(in_ptr(a, I_AQN) + 8 * lane + 4), gkv = *(const f32x4*)(in_ptr(a, I_AKVN) + 4 * lane);
    const float gbq1 = in_ptr(a, I_BQN)[d1], gbq2 = in_ptr(a, I_BQN)[d2], gbk1 = in_ptr(a, I_BKN)[d1], gbk2 = in_ptr(a, I_BKN)[d2];
    for (int row = gw; row < MPAD; row += NGW) {
        const bf16_t* z = Z + (size_t)row * ZLD; const int kr = kvrow(row);
        *(u32x2*)(VB + (size_t)kr * KB_LD + 4 * lane) = *(const u32x2*)(z + 2112 + 4 * lane);
        {
            const u32x4 w = *(const u32x4*)(z + 8 * lane);
            float x[8] = {bflo(w.x), bfhi(w.x), bflo(w.y), bfhi(w.y), bflo(w.z), bfhi(w.z), bflo(w.w), bfhi(w.w)};
            float ss = 0.f;
#pragma unroll
            for (int i = 0; i < 8; ++i) ss += x[i] * x[i];
            const float rs = rsqrtf(wave_sum(ss) * (1.0f / 512.0f) + RMS_EPS);
            u32x4 o; o.x = pkbf(x[0] * rs * gq0[0], x[1] * rs * gq0[1]); o.y = pkbf(x[2] * rs * gq0[2], x[3] * rs * gq0[3]);
            o.z = pkbf(x[4] * rs * gq1[0], x[5] * rs * gq1[1]); o.w = pkbf(x[6] * rs * gq1[2], x[7] * rs * gq1[3]);
            *(u32x4*)(CQN + (size_t)row * 512 + 8 * lane) = o;
        }
        {
            const u32x2 w = *(const u32x2*)(z + 512 + 4 * lane);
            const float x0 = bflo(w.x), x1 = bfhi(w.x), x2 = bflo(w.y), x3 = bfhi(w.y);
            const float rs = rsqrtf(wave_sum(x0 * x0 + x1 * x1 + x2 * x2 + x3 * x3) * (1.0f / 256.0f) + RMS_EPS);
            u32x2 o; o.x = pkbf(x0 * rs * gkv[0], x1 * rs * gkv[1]); o.y = pkbf(x2 * rs * gkv[2], x3 * rs * gkv[3]);
            *(u32x2*)(CKVN + (size_t)row * 256 + 4 * lane) = o;
        }
        if (lane < 32) {
            const float x1 = bf2f(z[768 + lane]), x2 = bf2f(z[800 + lane]);
            const float c = AC[(size_t)row * 32 + lane], s = AS[(size_t)row * 32 + lane];
            const unsigned pk = pkbf(x1 * c - x2 * s, x2 * c + x1 * s);
#pragma unroll
            for (int h = 0; h < 8; ++h) *(unsigned*)(KA + (size_t)kr * QA_LD + h * 192 + 128 + 2 * lane) = pk;
        }
        const float c = tc[(size_t)row * 32 + ti], s = ts[(size_t)row * 32 + ti];
#pragma unroll
        for (int h = 0; h < 10; ++h) {
            const bf16_t* zh = z + A_IN + 128 * h;
            float x1 = bf2f(zh[d1]), x2 = bf2f(zh[d2]);
            const float rs = rsqrtf(wave_sum(x1 * x1 + x2 * x2) * (1.0f / 128.0f) + RMS_EPS);
            x1 *= rs * (h < 8 ? gbq1 : gbk1); x2 *= rs * (h < 8 ? gbq2 : gbk2);
            const unsigned pk = pkbf(x1 * c - x2 * s, x2 * c + x1 * s);
            if (h < 8) *(unsigned*)(QB + (size_t)row * QB_LD + h * 128 + 2 * lane) = pk;
            else *(unsigned*)(KB + (size_t)kr * KB_LD + (h - 8) * 128 + 2 * lane) = pk;
        }
    }
}

template <bool SRC0, bool ROUTER, bool YSPLIT>
__device__ __forceinline__ void p_rownorm(const Ctx& F, const Args& a, const float* gpost, const float* gpre, const int nrows, float* dbg_out) {
    unsigned char* ws = ws_ptr(a);
    const int gw = F.vcu * NWAVES + F.wave, NGW = F.G * NWAVES, lane = F.lane;
    const bf16_t* Yb = (const bf16_t*)(ws + WS_Y); bf16_t* H = (bf16_t*)(ws + WS_H); bf16_t* A = (bf16_t*)(ws + WS_A);
    LAS f32x4* RL0 = (LAS f32x4*)(F.lds); LAS f32x4* RL1 = (LAS f32x4*)(F.lds + 32768);
    LAS unsigned* lcnt = (LAS unsigned*)(F.lds + 65536);
    if (ROUTER) {
        const float* R = in_ptr(a, I_ROUTER);
        for (int idx = F.tid; idx < 2048; idx += NWAVES * 64) {
            const int ln = idx & 63, q = idx >> 6, col = 8 * ln + 512 * (q >> 3) + (q & 7);
            RL0[q * 64 + ln] = *(const f32x4*)(R + (size_t)col * 8); RL1[q * 64 + ln] = *(const f32x4*)(R + (size_t)col * 8 + 4); }
        if (F.tid < 8) lcnt[F.tid] = 0u;
        __syncthreads();
    }
    for (int row = gw; row < nrows; row += NGW) {
        const bf16_t* yr = Yb + (size_t)row * 2048;
        const float* hb0 = row < SEQ ? in_ptr(a, I_X) + (size_t)row * 2048 : in_ptr(a, I_META) + (size_t)(row - SEQ) * 2048;
        f32x4 y[4][2], h[4][2]; float ss = 0.f;
#pragma unroll
        for (int j = 0; j < 4; ++j) {
            if (YSPLIT && row >= SEQ) {
#pragma unroll
                for (int q = 0; q < 2; ++q) { f32x4 s = (f32x4){0.f, 0.f, 0.f, 0.f};
#pragma unroll
                    for (int ks = 0; ks < 8; ++ks) s = s + *(const f32x4*)((const float*)(ws + WS_YP) + ((size_t)ks * 256 + (row - SEQ)) * 2048 + 512 * j + 8 * lane + 4 * q);
                    y[j][q] = s; }
            } else { const u32x4 w = *(const u32x4*)(yr + 512 * j + 8 * lane);
                y[j][0] = (f32x4){bflo(w.x), bfhi(w.x), bflo(w.y), bfhi(w.y)}; y[j][1] = (f32x4){bflo(w.z), bfhi(w.z), bflo(w.w), bfhi(w.w)}; }
            if (SRC0) { h[j][0] = *(const f32x4*)(hb0 + 512 * j + 8 * lane); h[j][1] = *(const f32x4*)(hb0 + 512 * j + 8 * lane + 4); }
            else { const u32x4 w = *(const u32x4*)(H + (size_t)row * 2048 + 512 * j + 8 * lane);
                h[j][0] = (f32x4){bflo(w.x), bfhi(w.x), bflo(w.y), bfhi(w.y)}; h[j][1] = (f32x4){bflo(w.z), bfhi(w.z), bflo(w.w), bfhi(w.w)}; }
#pragma unroll
            for (int q = 0; q < 2; ++q) ss += (y[j][q][0] * y[j][q][0] + y[j][q][1] * y[j][q][1]) + (y[j][q][2] * y[j][q][2] + y[j][q][3] * y[j][q][3]);
        }
        const float rs = rsqrtf(wave_sum(ss) * (1.0f / 2048.0f) + RMS_EPS);
        float ss2 = 0.f;
#pragma unroll
        for (int j = 0; j < 4; ++j) {
#pragma unroll
            for (int q = 0; q < 2; ++q) { const f32x4 g = *(const f32x4*)(gpost + 512 * j + 8 * lane + 4 * q);
                h[j][q] = h[j][q] + y[j][q] * rs * g;
                if (dbg_out && row < SEQ) *(f32x4*)(dbg_out + (size_t)row * 2048 + 512 * j + 8 * lane + 4 * q) = h[j][q];
                ss2 += (h[j][q][0] * h[j][q][0] + h[j][q][1] * h[j][q][1]) + (h[j][q][2] * h[j][q][2] + h[j][q][3] * h[j][q][3]); }
            u32x4 hw; hw.x = pkbf(h[j][0][0], h[j][0][1]); hw.y = pkbf(h[j][0][2], h[j][0][3]); hw.z = pkbf(h[j][1][0], h[j][1][1]); hw.w = pkbf(h[j][1][2], h[j][1][3]);
            *(u32x4*)(H + (size_t)row * 2048 + 512 * j + 8 * lane) = hw; }
        const float rs2 = rsqrtf(wave_sum(ss2) * (1.0f / 2048.0f) + RMS_EPS);
        float lg[8] = {0.f, 0.f, 0.f, 0.f, 0.f, 0.f, 0.f, 0.f};
#pragma unroll
        for (int j = 0; j < 4; ++j) {
            const f32x4 g0 = *(const f32x4*)(gpre + 512 * j + 8 * lane), g1 = *(const f32x4*)(gpre + 512 * j + 8 * lane + 4);
            const f32x4 x0 = h[j][0] * rs2 * g0, x1 = h[j][1] * rs2 * g1;
            u32x4 w; w.x = pkbf(x0[0], x0[1]); w.y = pkbf(x0[2], x0[3]); w.z = pkbf(x1[0], x1[1]); w.w = pkbf(x1[2], x1[3]);
            *(u32x4*)(A + (size_t)row * 2048 + 512 * j + 8 * lane) = w;
            if (ROUTER) {
#pragma unroll
                for (int i = 0; i < 8; ++i) { const float xv = i < 4 ? x0[i & 3] : x1[i & 3]; const f32x4 r0 = RL0[(j * 8 + i) * 64 + lane], r1 = RL1[(j * 8 + i) * 64 + lane];
                    lg[0] += xv * r0[0]; lg[1] += xv * r0[1]; lg[2] += xv * r0[2]; lg[3] += xv * r0[3]; lg[4] += xv * r1[0]; lg[5] += xv * r1[1]; lg[6] += xv * r1[2]; lg[7] += xv * r1[3]; }
            }
        }
        if (ROUTER) {
#pragma unroll
            for (int e = 0; e < 8; ++e) lg[e] = wave_sum(lg[e]);
            int e1 = 0; float v1 = lg[0];
#pragma unroll
            for (int e = 1; e < 8; ++e) if (lg[e] > v1) { v1 = lg[e]; e1 = e; }
            int e2 = -1; float v2 = -INFINITY;
#pragma unroll
            for (int e = 0; e < 8; ++e) if (e != e1 && lg[e] > v2) { v2 = lg[e]; e2 = e; }
            if (e2 < 0) e2 = (e1 + 1) & 7;
            const float g1 = 1.0f / (1.0f + __expf(v2 - v1)), g2 = 1.0f - g1;
            if (lane == 0) {
                const unsigned s1 = __hip_atomic_fetch_add(lcnt + e1, 1u, __ATOMIC_RELAXED, __HIP_MEMORY_SCOPE_WORKGROUP), s2 = __hip_atomic_fetch_add(lcnt + e2, 1u, __ATOMIC_RELAXED, __HIP_MEMORY_SCOPE_WORKGROUP);
                u32x4* ti = (u32x4*)(ws + WS_TOKINFO + (size_t)row * 32);
                ti[0] = (u32x4){(unsigned)e1, (unsigned)e2, s1, s2}; ti[1] = (u32x4){__float_as_uint(g1), __float_as_uint(g2), (unsigned)blockIdx.x, 0u};
            }
        }
    }
    if (ROUTER) {
        __syncthreads();
        if (F.tid < 8) { const unsigned base = __hip_atomic_fetch_add((unsigned*)(ws + WS_CTL) + CW_CNT + 64 * F.tid, lcnt[F.tid], RLX_AGENT);
            ((unsigned*)(ws + WS_WGBASE))[blockIdx.x * 8 + F.tid] = base; }
    }
}


__device__ __forceinline__ void p15_dispatch(const Ctx& F, const Args& a) {
    unsigned char* ws = ws_ptr(a);
    const int gw = F.vcu * NWAVES + F.wave, NGW = F.G * NWAVES, lane = F.lane;
    const unsigned* ctl = (const unsigned*)(ws + WS_CTL);
    unsigned pst[8]; unsigned acc = 0u;
#pragma unroll
    for (int e = 0; e < 8; ++e) { const unsigned c = __hip_atomic_load(ctl + CW_CNT + 64 * e, RLX_AGENT); pst[e] = acc; acc += (c + 255u) & ~255u; }
    if (blockIdx.x == 0 && F.tid == 0) {
        int* be = (int*)(ws + WS_BLKE);
#pragma unroll
        for (int e = 0; e < 8; ++e) { const unsigned b0 = pst[e] >> 8, b1 = (e < 7 ? pst[e < 7 ? e + 1 : 7] : acc) >> 8; for (unsigned b = b0; b < b1; ++b) be[b] = e; }
        *((unsigned*)(ws + WS_CTL) + CW_NBLK) = acc >> 8;
    }
    const bf16_t* A = (const bf16_t*)(ws + WS_A); unsigned char* XS8 = ws + WS_XS;
    const unsigned* wgb = (const unsigned*)(ws + WS_WGBASE);
    for (int row = gw; row < SEQ; row += NGW) {
        const u32x4* ti = (const u32x4*)(ws + WS_TOKINFO + (size_t)row * 32);
        const u32x4 i0 = ti[0], i1 = ti[1];
        const unsigned e1 = i0.x, e2 = i0.y, wg = i1.z;
        unsigned p1 = 0u, p2 = 0u;
#pragma unroll
        for (int e = 0; e < 8; ++e) { if ((unsigned)e == e1) p1 = pst[e]; if ((unsigned)e == e2) p2 = pst[e]; }
        const unsigned r1 = p1 + wgb[wg * 8 + e1] + i0.z, r2 = p2 + wgb[wg * 8 + e2] + i0.w;
#pragma unroll
        for (int j = 0; j < 4; ++j) { const u32x4 v = *(const u32x4*)(A + (size_t)row * 2048 + 512 * j + 8 * lane);
            u32x2 o; o.x = pkf8x4(bflo(v.x) * SC_X, bfhi(v.x) * SC_X, bflo(v.y) * SC_X, bfhi(v.y) * SC_X); o.y = pkf8x4(bflo(v.z) * SC_X, bfhi(v.z) * SC_X, bflo(v.w) * SC_X, bfhi(v.w) * SC_X);
            const size_t ko = (size_t)(4 * j + (lane >> 4)) * 32768 + (lane & 15) * 8;
            *(u32x2*)(XS8 + (size_t)(r1 >> 8) * (16 * 32768) + ko + (r1 & 255) * 128) = o; *(u32x2*)(XS8 + (size_t)(r2 >> 8) * (16 * 32768) + ko + (r2 & 255) * 128) = o; }
        if (lane == 0) *(u32x4*)(ws + WS_TOKDEST + (size_t)row * 16) = (u32x4){r1, r2, i1.x, i1.y};
    }
}

__device__ __forceinline__ void p18_final(const Ctx& F, const Args& a) {
    unsigned char* ws = ws_ptr(a);
    const int gw = F.vcu * NWAVES + F.wave, NGW = F.G * NWAVES, lane = F.lane;
    const bf16_t* Y2 = (const bf16_t*)(ws + WS_Y2); const bf16_t* H = (const bf16_t*)(ws + WS_H); const float* gpost = in_ptr(a, I_OFFN_POST);
    for (int row = gw; row < SEQ; row += NGW) {
        const u32x4 td = *(const u32x4*)(ws + WS_TOKDEST + (size_t)row * 16);
        const float g1 = __uint_as_float(td.z) * (1.0f / SC_Y), g2 = __uint_as_float(td.w) * (1.0f / SC_Y);
        float y[4][8]; float ss = 0.f;
        const unsigned char* Y8 = (const unsigned char*)Y2;
#pragma unroll
        for (int j = 0; j < 4; ++j) { const u32x2 wa = *(const u32x2*)(Y8 + (size_t)td.x * 2048 + 512 * j + 8 * lane), wb = *(const u32x2*)(Y8 + (size_t)td.y * 2048 + 512 * j + 8 * lane);
            typedef float f32x2v __attribute__((ext_vector_type(2)));
            const f32x2v a0 = __builtin_amdgcn_cvt_pk_f32_fp8((int)wa.x, false), a1 = __builtin_amdgcn_cvt_pk_f32_fp8((int)wa.x, true), a2 = __builtin_amdgcn_cvt_pk_f32_fp8((int)wa.y, false), a3 = __builtin_amdgcn_cvt_pk_f32_fp8((int)wa.y, true);
            const f32x2v b0 = __builtin_amdgcn_cvt_pk_f32_fp8((int)wb.x, false), b1 = __builtin_amdgcn_cvt_pk_f32_fp8((int)wb.x, true), b2 = __builtin_amdgcn_cvt_pk_f32_fp8((int)wb.y, false), b3 = __builtin_amdgcn_cvt_pk_f32_fp8((int)wb.y, true);
            y[j][0] = g1 * a0.x + g2 * b0.x; y[j][1] = g1 * a0.y + g2 * b0.y; y[j][2] = g1 * a1.x + g2 * b1.x; y[j][3] = g1 * a1.y + g2 * b1.y;
            y[j][4] = g1 * a2.x + g2 * b2.x; y[j][5] = g1 * a2.y + g2 * b2.y; y[j][6] = g1 * a3.x + g2 * b3.x; y[j][7] = g1 * a3.y + g2 * b3.y;
#pragma unroll
            for (int i = 0; i < 8; ++i) ss += y[j][i] * y[j][i]; }
        const float rs = rsqrtf(wave_sum(ss) * (1.0f / 2048.0f) + RMS_EPS);
#pragma unroll
        for (int j = 0; j < 4; ++j) { const u32x4 hw = *(const u32x4*)(H + (size_t)row * 2048 + 512 * j + 8 * lane);
            const float hvv[8] = {bflo(hw.x), bfhi(hw.x), bflo(hw.y), bfhi(hw.y), bflo(hw.z), bfhi(hw.z), bflo(hw.w), bfhi(hw.w)};
#pragma unroll
            for (int q = 0; q < 2; ++q) { const int col = 512 * j + 8 * lane + 4 * q; const f32x4 g = *(const f32x4*)(gpost + col);
                f32x4 o; o[0] = hvv[4 * q + 0] + y[j][4 * q + 0] * rs * g[0]; o[1] = hvv[4 * q + 1] + y[j][4 * q + 1] * rs * g[1]; o[2] = hvv[4 * q + 2] + y[j][4 * q + 2] * rs * g[2]; o[3] = hvv[4 * q + 3] + y[j][4 * q + 3] * rs * g[3];
                *(f32x4*)(a.out + (size_t)row * 2048 + col) = o; } }
    }
}
#ifndef DBG_STOP
#define DBG_STOP 0
#endif
#ifndef MK_PER_PHASE
#define MK_PER_PHASE 0
#endif
constexpr int N_PHASES = 19;
#ifndef DBG_LAST
#define DBG_LAST 18
#endif
constexpr int LAST_PHASE0 = (DBG_STOP == 1) ? 7 : (DBG_STOP == 2) ? 10 : (DBG_STOP == 3) ? 14 : 18;
constexpr int LAST_PHASE = LAST_PHASE0 < DBG_LAST ? LAST_PHASE0 : DBG_LAST;

__global__ void __launch_bounds__(NWAVES * 64, 2) enc_fwd(Args args) {
    extern __shared__ __attribute__((aligned(16))) unsigned char lds_raw[];
    Ctx F;
    F.lds = (LAS unsigned char*)lds_raw;
    volatile LAS unsigned* MISC = (volatile LAS unsigned*)(F.lds + MISC_OFF);
    F.wave = __builtin_amdgcn_readfirstlane((int)threadIdx.x >> 6); F.lane = lane_id_asm(); F.tid = F.wave * 64 + F.lane;
    F.G = gridDim.x; { const int bx = blockIdx.x; F.vcu = (F.G % 8 == 0) ? (bx % 8) * (F.G / 8) + bx / 8 : bx; }
    unsigned char* ws = ws_ptr(args);
    for (int u = F.tid; u < (LDS_BYTES - LDSCTL_OFF) / 4; u += NWAVES * 64) ((LAS unsigned*)(F.lds + LDSCTL_OFF))[u] = 0u;
    __syncthreads();
    XcdBarrier bar; bar.bar = (unsigned*)(ws + WS_CTL) + CW_BAR; bar.x = 0; bar.st = nullptr;
    if (!MK_PER_PHASE) bar = xcd_barrier_post((unsigned*)(ws + WS_CTL) + CW_BAR, MISC + 8, F.tid == 0);
    const int lo = args.ph_lo, hi = args.ph_hi;
#ifndef P16_WGM
#define P16_WGM 8
#endif
#ifndef P9_WGM
#define P9_WGM 8
#endif
#ifndef PH_MASK
#define PH_MASK 0x7FFFF
#endif
#define IN(k) ((((PH_MASK) >> (k)) & 1) && lo <= (k) && (k) < hi)
#define RETID() do { F.lane = lane_id_asm(); F.tid = F.wave * 64 + F.lane; ws = ws_ptr(args); A = (bf16_t*)(ws + WS_A); O = (bf16_t*)(ws + WS_O); Y = (float*)(ws + WS_Y); } while (0)
#define SEAM(k) do { if (!MK_PER_PHASE && IN(k) && IN((k) + 1)) { xcd_barrier(bar, (F.wave * 64 + lane_id_asm()) == 0); } RETID(); } while (0)
    bf16_t* A = (bf16_t*)(ws + WS_A);
    bf16_t* O = (bf16_t*)(ws + WS_O);
    float* Y = (float*)(ws + WS_Y);

     if (IN(0)) { p0_prologue(F, args); }  SEAM(0);
     if (IN(1)) {
        pg8::Gemm g{A, (const bf16_t*)(ws + WS_W_IN), MPAD, ZLD, 2048}; pg8::StaticOrder S; S.init(MPAD, ZLD, F.G, (int)blockIdx.x);
        pg8::EpiBf16<0> E{(bf16_t*)(ws + WS_Z), ZLD, nullptr, 0, 0, 1.f};
        pg8::gemm_phase<pg8::EpiBf16<0>, pg8::StaticOrder, true, true>(F.lds, g, S, E, F.wave);
        if ((int)blockIdx.x >= 138 && F.G == 256) {
            F.lane = lane_id_asm(); cvt_big(F, args, CVT_NITEMS - CVT_RX1 - CVT_RX11, CVT_NITEMS - CVT_RX11, (int)blockIdx.x - 138, 118); }
    }  SEAM(1);
     if (IN(2)) { p2_postz(F, args); }  SEAM(2);
     if (IN(3)) {
        { pg8::Gemm g{(const bf16_t*)(ws + WS_CQN), (const bf16_t*)(ws + WS_W_QB), MPAD, 1536, 512}; pg8::StaticOrder S; S.init(MPAD, 1536, F.G, (int)blockIdx.x);
          EpiQA E{(bf16_t*)(ws + WS_QA), (const float*)(ws + WS_AC), (const float*)(ws + WS_AS)};
          pg8::gemm_phase<EpiQA, pg8::StaticOrder, true, true>(F.lds, g, S, E, F.wave); }
        { pg8::Gemm g{(const bf16_t*)(ws + WS_CKVN), (const bf16_t*)(ws + WS_W_KVB), MPAD, 2048, 256}; pg8::StaticOrder S;
          S.init(MPAD, 2048, F.G, F.G == 256 ? (int)((blockIdx.x + 120u) & 255u) : (int)blockIdx.x);
          EpiKV E{(bf16_t*)(ws + WS_KA), (bf16_t*)(ws + WS_VA)};
          pg8::gemm_phase<EpiKV, pg8::StaticOrder, true, true>(F.lds, g, S, E, F.wave); }
    }  SEAM(3);
     if (IN(4)) {
        constexpr int NT_ALL = 258;
        const int slot = F.vcu % 3;
        int u = F.vcu;
        if (slot == 0) { F.lane = lane_id_asm(); cvt_big(F, args, 0, F.G == 256 ? CVT_NITEMS - CVT_RX1 - CVT_RX11 : CVT_NITEMS, F.vcu, F.G); __syncthreads(); }
        for (; u < 512; u += F.G) { unsigned char* w2 = ws_ptr(args); const int r = u & 511, h = (r & 255) >> 5, qb = (r & 31) + 32 * (r >> 8);
            att::dense_unit<192, QA_LD, QA_LD, VA_LD, 2048, 1, 12>((const bf16_t*)(w2 + WS_QA) + (size_t)qb * 256 * QA_LD + h * 192, (const bf16_t*)(w2 + WS_KA) + h * 192, (const bf16_t*)(w2 + WS_VA) + h * 128, NT_ALL, N_META, 0, 0.07216878364870322f,
                                                              (bf16_t*)(w2 + WS_O) + (size_t)qb * 256 * 2048 + h * 128, nullptr, (LAS char*)F.lds, F.wave); }
        if (slot == 1) { __syncthreads(); F.lane = lane_id_asm(); cvt_big(F, args, 0, F.G == 256 ? CVT_NITEMS - CVT_RX1 - CVT_RX11 : CVT_NITEMS, F.vcu, F.G); __syncthreads(); }
        for (; u < 1024; u += F.G) { unsigned char* w2 = ws_ptr(args); const int r = u & 511, h = (r & 255) >> 5, qb = (r & 31) + 32 * (r >> 8), kvh = h >> 2;
            att::dense_unit<128, QB_LD, KB_LD, KB_LD, 2048, 2, 8>((const bf16_t*)(w2 + WS_QB) + (size_t)qb * 256 * QB_LD + h * 128, (const bf16_t*)(w2 + WS_KB) + kvh * 128, (const bf16_t*)(w2 + WS_VB) + kvh * 128, NT_ALL, N_META, 0, 0.08838834764831845f,
                                                             (bf16_t*)(w2 + WS_O) + (size_t)qb * 256 * 2048 + 1024 + h * 128, nullptr, (LAS char*)F.lds, F.wave); }
        if (slot == 2) { __syncthreads(); F.lane = lane_id_asm(); cvt_big(F, args, 0, F.G == 256 ? CVT_NITEMS - CVT_RX1 - CVT_RX11 : CVT_NITEMS, F.vcu, F.G); __syncthreads(); }
        for (; u < 1280; u += F.G) { unsigned char* w2 = ws_ptr(args); const int r = u - 1024, hh = r >> 4, ch = r & 15, t0 = 16 * ch, nt = (ch == 15) ? NT_ALL - 240 : 16;
            float* part = (float*)(w2 + WS_ACT) + (size_t)r * 256 * 132;
            if (hh < 8) att::dense_unit<192, QA_LD, QA_LD, VA_LD, 2048, 1, 12>((const bf16_t*)(w2 + WS_QA) + (size_t)SEQ * QA_LD + hh * 192, (const bf16_t*)(w2 + WS_KA) + (size_t)t0 * 64 * QA_LD + hh * 192, (const bf16_t*)(w2 + WS_VA) + (size_t)t0 * 64 * VA_LD + hh * 128,
                                                                          nt, ch == 0 ? N_META : 64, ch == 15 ? 0 : 64, 0.07216878364870322f, nullptr, part, (LAS char*)F.lds, F.wave);
            else { const int h = hh - 8, kvh = h >> 2;
                att::dense_unit<128, QB_LD, KB_LD, KB_LD, 2048, 2, 8>((const bf16_t*)(w2 + WS_QB) + (size_t)SEQ * QB_LD + h * 128, (const bf16_t*)(w2 + WS_KB) + (size_t)t0 * 64 * KB_LD + kvh * 128, (const bf16_t*)(w2 + WS_VB) + (size_t)t0 * 64 * KB_LD + kvh * 128,
                                                                 nt, ch == 0 ? N_META : 64, ch == 15 ? 0 : 64, 0.08838834764831845f, nullptr, part, (LAS char*)F.lds, F.wave); } }
    }  SEAM(4);
     if (IN(5)) {
        const float* PART = (const float*)(ws + WS_ACT);
        for (int idx = blockIdx.x * (NWAVES * 64) + F.tid; idx < 16 * 16 * 128; idx += F.G * NWAVES * 64) {
            const int hh = idx >> 11, row = (idx >> 7) & 15, col = idx & 127;
#if defined(SRCC) && defined(SRCC_ALL)
            const float C = 1.f;
#elif defined(SRCC)
            const float C = hh < 8 ? 0.07216878364870322f * 1.4426950408889634f : 1.f;
#else
            const float C = (hh < 8 ? 0.07216878364870322f : 0.08838834764831845f) * 1.4426950408889634f;
#endif
            const float* p = PART + ((size_t)hh * 16 * 256 + row) * 132;
            float M = -1e30f;
#pragma unroll
            for (int c = 0; c < 16; ++c) M = fmaxf(M, p[(size_t)c * 256 * 132 + 128]);
            float num = 0.f, den = 0.f;
#pragma unroll
            for (int c = 0; c < 16; ++c) { const float* pc = p + (size_t)c * 256 * 132; const float w = __builtin_amdgcn_exp2f((pc[128] - M) * C); num += pc[col] * w; den += pc[129] * w; }
            O[(size_t)(SEQ + row) * 2048 + hh * 128 + col] = (bf16_t)(pkbf(num / den, 0.f) & 0xffffu);
        }
    }  SEAM(5);
     if (IN(6)) {
        pg8::Gemm g{O, (const bf16_t*)(ws + WS_W_OUT), MPAD, 2048, 2048}; MetaSplitOrder S; S.init(8, 2048, 8, F.G, (int)blockIdx.x);
        EpiYBf16 E{(bf16_t*)Y, 2048, nullptr, (float*)(ws + WS_YP), 256};
        pg8::gemm_phase<EpiYBf16, MetaSplitOrder, true, true>(F.lds, g, S, E, F.wave);
    }  SEAM(6);
     if (IN(7)) { p_rownorm<true, false, true>(F, args, in_ptr(args, I_EATTN_POST), in_ptr(args, I_EFFN_PRE), L_TOK, DBG_STOP == 1 ? args.out : nullptr); }  SEAM(7);
     if (IN(8)) {
        { pg8::Gemm g{A, (const bf16_t*)(ws + WS_W_GU), MPAD, 2 * D_FF, 2048}; MetaSplitOrder S; S.init(56, 2048, 4, F.G, (int)blockIdx.x);
          EpiSwiGLU E{(bf16_t*)(ws + WS_ACT), D_FF, 56, 1, (float*)(ws + WS_YP)};
          pg8::gemm_phase<EpiSwiGLU, MetaSplitOrder, true, true>(F.lds, g, S, E, F.wave); }
        xcd_barrier(bar, (F.wave * 64 + lane_id_asm()) == 0); RETID();
        { const float* SP = (const float*)(ws + WS_YP); bf16_t* ACT = (bf16_t*)(ws + WS_ACT);
          for (int idx = F.vcu * (NWAVES * 64) + F.wave * 64 + lane_id_asm(); idx < 56 * 16 * 32; idx += F.G * NWAVES * 64) {
              const int pn = idx >> 9, r = (idx >> 5) & 15, j4 = (idx & 31) * 4;
              f32x4 gg = (f32x4){0.f, 0.f, 0.f, 0.f}, uu = gg;
#pragma unroll
              for (int sl = 0; sl < 4; ++sl) { const float* q = SP + ((size_t)(sl * 56 + pn) * 16 + r) * 256 + j4; gg = gg + *(const f32x4*)q; uu = uu + *(const f32x4*)(q + 128); }
              const int col = pn * 128 + j4;
              u32x2 w; w.x = pkbf(silu_f(gg[0]) * uu[0], silu_f(gg[1]) * uu[1]); w.y = pkbf(silu_f(gg[2]) * uu[2], silu_f(gg[3]) * uu[3]);
              *(u32x2*)(ACT + ((size_t)(64 * (D_FF >> 6) + (col >> 6))) * 16384 + r * 64 + (col & 63)) = w; } }
    }  SEAM(8);
     if (IN(9)) {
        pg8::Gemm g{(const bf16_t*)(ws + WS_ACT), (const bf16_t*)(ws + WS_W_DN), MPAD, 2048, D_FF}; MetaSplitOrder S; S.init(8, D_FF, 8, F.G, (int)blockIdx.x, P9_WGM);
        EpiYBf16 E{(bf16_t*)Y, 2048, nullptr, (float*)(ws + WS_YP), D_FF / 8};
        pg8::gemm_phase<EpiYBf16, MetaSplitOrder, true, true, true>(F.lds, g, S, E, F.wave);
    }
#if defined(PROBE_P9)
    if (IN(9)) {
        __syncthreads();
        pg8::Gemm g{(const bf16_t*)(ws + WS_ACT), (const bf16_t*)(ws + WS_W_DN), MPAD, 2048, D_FF}; ProbeOrder S; S.S.init(8, D_FF, 8, F.G, (int)blockIdx.x); S.zpm = (PROBE_P9) & 1; S.zpn = ((PROBE_P9) >> 1) & 1;
        EpiF32 E{(float*)(ws + WS_XS), 2048, nullptr, (float*)(ws + WS_Y2), D_FF / 8};
        pg8::gemm_phase<EpiF32, ProbeOrder, true, true, true>(F.lds, g, S, E, F.wave);
    }
#endif
    SEAM(9);
     if (IN(10)) { p_rownorm<false, false, true>(F, args, in_ptr(args, I_EFFN_POST), in_ptr(args, I_OATTN_PRE), L_TOK, DBG_STOP == 2 ? args.out : nullptr); }  SEAM(10);
     if (IN(11)) {
        pg8::Gemm g{A, (const bf16_t*)(ws + WS_W_QKV), MPAD, C_QKV, 2048}; RowsPlusOrder S; S.init(64, 10, 8, F.G, (int)blockIdx.x);
        EpiQKV E{(bf16_t*)(ws + WS_QKV), (const float*)(ws + WS_BIASP), (const float*)(ws + WS_CC), (const float*)(ws + WS_CS)};
        pg8::gemm_phase<EpiQKV, RowsPlusOrder, true, true>(F.lds, g, S, E, F.wave);
        if ((int)blockIdx.x >= 130 && F.G == 256) {
            F.lane = lane_id_asm(); cvt_big(F, args, CVT_NITEMS - CVT_RX11, CVT_NITEMS, (int)blockIdx.x - 130, 126); }
    }  SEAM(11);
     if (IN(12)) {
        for (int u = F.vcu; u < 512; u += F.G) att::wattn_unit((const bf16_t*)(ws + WS_QKV), O, in_ptr(args, I_CSINK), u >> 7, u & 127, (LAS char*)F.lds, F.wave);
        __syncthreads();
    }  SEAM(12);
     if (IN(13)) {
        pg8::Gemm g{O, (const bf16_t*)(ws + WS_W_CO), SEQ, 2048, 2048}; pg8::StaticOrder S; S.init(SEQ, 2048, F.G, (int)blockIdx.x);
        EpiYBf16 E{(bf16_t*)Y, 2048, in_ptr(args, I_CBOUT), nullptr, 1};
        pg8::gemm_phase<EpiYBf16, pg8::StaticOrder, true, true>(F.lds, g, S, E, F.wave);
    }  SEAM(13);
     if (IN(14)) { p_rownorm<false, true, false>(F, args, in_ptr(args, I_OATTN_POST), in_ptr(args, I_OFFN_PRE), SEQ, DBG_STOP == 3 ? args.out : nullptr); }  SEAM(14);
     if (IN(15)) { p15_dispatch(F, args); }  SEAM(15);
     if (IN(16)) {
        const int nblk = (int)__hip_atomic_load((const unsigned*)(ws + WS_CTL) + CW_NBLK, RLX_AGENT);
        pg8::Gemm g{(const bf16_t*)(ws + WS_XS), (const bf16_t*)(ws + WS_W_MGU), nblk * 256, 2 * D_FF, 2048}; MoeOrder S; S.init(nblk, 56, F.G, (int)blockIdx.x, (const int*)(ws + WS_BLKE), P16_WGM);
        EpiSwiGLU8 E{ws + WS_ACT2, D_FF, 56, 1.0f / (SC_X * SC_WGU), SC_ACT};
        pg8::gemm_phase<EpiSwiGLU8, MoeOrder, true, true, true, true>(F.lds, g, S, E, F.wave);
    }  SEAM(16);
     if (IN(17)) {
        const int nblk = (int)__hip_atomic_load((const unsigned*)(ws + WS_CTL) + CW_NBLK, RLX_AGENT);
        { pg8::Gemm g{(const bf16_t*)(ws + WS_ACT2), (const bf16_t*)(ws + WS_W_MDN), nblk * 256, 2048, D_FF}; MoeTailOrder S; S.init(nblk, 8, D_FF, F.G, (int)blockIdx.x, (const int*)(ws + WS_BLKE));
          EpiMoeDown E{(bf16_t*)(ws + WS_Y2), 2048, 8, (float*)(ws + WS_XS), 1.0f / (SC_ACT * SC_WDN)};
          pg8::gemm_phase<EpiMoeDown, MoeTailOrder, true, true, true, true>(F.lds, g, S, E, F.wave); }
        const int U = nblk * 8, RG = (U / F.G) * F.G, Lf = U - RG, sp = MoeTailOrder::pick_s(Lf, F.G);
        if (sp > 1) {
            xcd_barrier(bar, (F.wave * 64 + lane_id_asm()) == 0); RETID();
            pg8::StaticOrder SM; SM.init(nblk * 256, 8 * 256, F.G, (int)blockIdx.x);
            const float* SP = (const float*)(ws + WS_XS); bf16_t* Y2 = (bf16_t*)(ws + WS_Y2);
            for (int idx = F.vcu * NWAVES + F.wave; idx < Lf * 256; idx += F.G * NWAVES) {
                const int j = idx >> 8, r = idx & 255; pg8::Unit u; SM.map(RG + j, u);
                f32x4 sacc = (f32x4){0.f, 0.f, 0.f, 0.f};
                for (int ks = 0; ks < sp; ++ks) sacc = sacc + *(const f32x4*)(SP + (size_t)(j * sp + ks) * 65536 + r * 256 + 4 * F.lane);
                *(unsigned*)((unsigned char*)Y2 + (size_t)(u.pm * 256 + r) * 2048 + u.pn * 256 + 4 * F.lane) = pkf8x4(sacc[0] * SC_Y, sacc[1] * SC_Y, sacc[2] * SC_Y, sacc[3] * SC_Y);
            }
        }
    }  SEAM(17);
     if (IN(18)) { p18_final(F, args); }
#undef IN
#undef SEAM
}

extern "C" void kernel_launch(void* const* d_in, const int* in_sizes, int n_in, void* d_out, int out_size, void* d_ws, size_t ws_size, hipStream_t stream) {
    static int grid = 0;
    if (grid == 0) {
        if (n_in != 30 || in_sizes[0] != SEQ * D_MODEL || out_size != SEQ * D_MODEL || ws_size < WS_END) {
            fprintf(stderr, "kernel_launch: shape mismatch: n_in %d in0 %d out %d ws %zu (need >= %zu); nothing launched\n", n_in, n_in > 0 ? in_sizes[0] : -1, out_size, ws_size, (size_t)WS_END); grid = -1; return; }
        int dev = 0, cus = 0, per_cu = 0;
        if (hipGetDevice(&dev) != hipSuccess || hipDeviceGetAttribute(&cus, hipDeviceAttributeMultiprocessorCount, dev) != hipSuccess) { grid = -1; return; }
        if (hipFuncSetAttribute((const void*)enc_fwd, hipFuncAttributeMaxDynamicSharedMemorySize, LDS_BYTES) != hipSuccess) { fprintf(stderr, "kernel_launch: hipFuncSetAttribute failed\n"); grid = -1; return; }
        if (hipOccupancyMaxActiveBlocksPerMultiprocessor(&per_cu, (const void*)enc_fwd, NWAVES * 64, LDS_BYTES) != hipSuccess || per_cu < 1)
            fprintf(stderr, "kernel_launch: occupancy query reports %d workgroups per CU\n", per_cu);
        (void)hipGetLastError();
        grid = cus;
    }
    if (grid < 0) return;
    if (hipMemsetAsync((char*)d_ws + WS_CTL, 0, CTL_ZERO_BYTES, stream) != hipSuccess) { fprintf(stderr, "kernel_launch: memset failed\n"); return; }
    Args a{};
    for (int i = 0; i < 30; ++i) a.in[i] = (const float*)d_in[i];
    a.out = (float*)d_out; a.ws = (unsigned char*)d_ws;
#if MK_PER_PHASE
    for (int p = 0; p <= LAST_PHASE; ++p) { a.ph_lo = p; a.ph_hi = p + 1; hipLaunchKernelGGL(enc_fwd, dim3(grid), dim3(NWAVES * 64), LDS_BYTES, stream, a); }
#else
    a.ph_lo = 0; a.ph_hi = LAST_PHASE + 1;
    hipLaunchKernelGGL(enc_fwd, dim3(grid), dim3(NWAVES * 64), LDS_BYTES, stream, a);
#endif
    const hipError_t le = hipPeekAtLastError();
    if (le != hipSuccess) fprintf(stderr, "kernel_launch: launch failed: %s\n", hipGetErrorName(le));
}
```
